# Optimizing an MI355X kernel written in HIP

```python
import jax, jax.numpy as jnp
from jax import lax
import numpy as np

D_MODEL = 1024
BATCH = 4
SEQ = 8192
DEPTH = 2

GRID_W = 64
CTX_LEN = 256
ROPE_THETA = 10000.0
Q_BLOCK = 128
EPS = 1e-6

A_HEADS = 8
A_NOPE = 64
A_ROPE = 32
A_V = 64
A_Q_RANK = 384
A_KV_RANK = 256
A_WIDTH = A_HEADS * A_V
A_SCALE = (A_NOPE + A_ROPE) ** -0.5

B_HEADS = 8
B_KV_HEADS = 2
B_GROUP = B_HEADS // B_KV_HEADS
B_HD = 64
B_WIDTH = B_HEADS * B_HD
B_SCALE = B_HD ** -0.5

EVEN_WIDTH = A_WIDTH + B_WIDTH
EVEN_SPLITS = [A_Q_RANK, A_KV_RANK, A_ROPE, A_WIDTH,
               B_HEADS * B_HD, B_KV_HEADS * B_HD, B_KV_HEADS * B_HD, B_WIDTH]
EVEN_IN = sum(EVEN_SPLITS)

C_CHUNK = 128
C_GROUPS = 8
C_WIDTH = 1024
C_GROUP_W = C_WIDTH // C_GROUPS
ODD_IN = 3 * C_WIDTH

N_EVEN = (DEPTH + 1) // 2
N_ODD = DEPTH // 2
DEEPNORM_ALPHA = (2 * DEPTH) ** 0.25
DEEPNORM_BETA = (8 * DEPTH) ** -0.25

kernel_name = 'hybrid_mla_gqa_gmlp_prefix_dit'


def rms_norm(x, g):
    xf = x.astype(jnp.float32)
    y = xf * lax.rsqrt(jnp.mean(xf * xf, axis=-1, keepdims=True) + EPS)
    return (y * g.astype(jnp.float32)).astype(x.dtype)


def layer_norm(x, g, b):
    xf = x.astype(jnp.float32)
    mu = jnp.mean(xf, axis=-1, keepdims=True)
    var = jnp.mean(jnp.square(xf - mu), axis=-1, keepdims=True)
    y = (xf - mu) * lax.rsqrt(var + EPS)
    return (y * g.astype(jnp.float32) + b.astype(jnp.float32)).astype(x.dtype)


def modulation(cond, w_mod, b_mod):
    m = jax.nn.silu(cond) @ w_mod + b_mod
    return jnp.split(m, 3, axis=-1)


def modulate(x, shift, scale):
    return x * (1.0 + scale) + shift


def axial_rope_angles(n_tok, d_rot):
    rows = n_tok // GRID_W
    row = jnp.repeat(jnp.arange(rows, dtype=jnp.float32), GRID_W)
    col = jnp.tile(jnp.arange(GRID_W, dtype=jnp.float32), rows)
    d_axis = d_rot // 2
    inv_freq = ROPE_THETA ** (-jnp.arange(0, d_axis, 2, dtype=jnp.float32) / d_axis)
    ang = jnp.stack([row[:, None] * inv_freq, col[:, None] * inv_freq], axis=1)
    return (jnp.cos(ang), jnp.sin(ang))


def apply_axial_rope(x, cos, sin):
    b, s, h, d = x.shape
    xa = x.reshape(b, s, h, 2, d // 2)
    x1, x2 = jnp.split(xa, 2, axis=-1)
    cs = cos[None, :, None].astype(x.dtype)
    sn = sin[None, :, None].astype(x.dtype)
    out = jnp.concatenate([x1 * cs - x2 * sn, x2 * cs + x1 * sn], axis=-1)
    return out.reshape(b, s, h, d)


def block_attention(q, k, v, scale):
    b, s, hk, g, dk = q.shape
    nb = s // Q_BLOCK
    qb = jnp.moveaxis(q.reshape(b, nb, Q_BLOCK, hk, g, dk), 1, 0)

    def one_block(qi):
        sc = jnp.einsum('bqhgd,bthd->bhgqt', qi, k).astype(jnp.float32) * scale
        p = jax.nn.softmax(sc, axis=-1).astype(v.dtype)
        return jnp.einsum('bhgqt,bthe->bqhge', p, v)

    out = lax.map(one_block, qb)
    return jnp.moveaxis(out, 0, 1).reshape(b, s, hk, g, v.shape[-1])


def even_heads(h, a_q_norm, a_kv_norm, a_w_uq, a_w_ukv, b_q_norm, b_k_norm, rope):
    bsz, n, _ = h.shape
    idx = [int(i) for i in np.cumsum(EVEN_SPLITS)[:-1]]
    cq, ckv, kr, g_a, qb, kb, vb, g_b = jnp.split(h, idx, axis=-1)
    q_a = (rms_norm(cq, a_q_norm) @ a_w_uq).reshape(bsz, n, A_HEADS, A_NOPE + A_ROPE)
    kv_a = (rms_norm(ckv, a_kv_norm) @ a_w_ukv).reshape(bsz, n, A_HEADS, A_NOPE + A_V)
    q_nope, q_pe = q_a[..., :A_NOPE], q_a[..., A_NOPE:]
    k_nope, v_a = kv_a[..., :A_NOPE], kv_a[..., A_NOPE:]
    k_pe = kr.reshape(bsz, n, 1, A_ROPE)
    q_b = rms_norm(qb.reshape(bsz, n, B_HEADS, B_HD), b_q_norm)
    k_b = rms_norm(kb.reshape(bsz, n, B_KV_HEADS, B_HD), b_k_norm)
    v_b = vb.reshape(bsz, n, B_KV_HEADS, B_HD)
    if rope is not None:
        cos_a, sin_a, cos_b, sin_b = rope
        q_pe = apply_axial_rope(q_pe, cos_a, sin_a)
        k_pe = apply_axial_rope(k_pe, cos_a, sin_a)
        q_b = apply_axial_rope(q_b, cos_b, sin_b)
        k_b = apply_axial_rope(k_b, cos_b, sin_b)
    q_a = jnp.concatenate([q_nope, q_pe], axis=-1)
    k_a = jnp.concatenate([k_nope, jnp.broadcast_to(k_pe, (bsz, n, A_HEADS, A_ROPE))], axis=-1)
    return (q_a, k_a, v_a, g_a, q_b, k_b, v_b, g_b)


def attend_and_merge(q_a, k_a, v_a, q_b, k_b, v_b, g_a, g_b, w_out):
    bsz, n = q_a.shape[:2]
    o_a = block_attention(q_a[:, :, :, None], k_a, v_a, A_SCALE).reshape(bsz, n, A_WIDTH)
    o_b = block_attention(q_b.reshape(bsz, n, B_KV_HEADS, B_GROUP, B_HD), k_b, v_b,
                          B_SCALE).reshape(bsz, n, B_WIDTH)
    merged = jnp.concatenate([o_a * jax.nn.silu(g_a), o_b * jax.nn.silu(g_b)], axis=-1)
    return merged @ w_out


def even_layer(x, xc, c, c_ctx, w_mod, b_mod, w_in, a_q_norm, a_kv_norm, a_w_uq, a_w_ukv,
               b_q_norm, b_k_norm, w_out, ln_g, ln_b, update_ctx):
    n = x.shape[1]
    rope = axial_rope_angles(n, A_ROPE) + axial_rope_angles(n, B_HD)
    shift, scale, gate = modulation(c[:, None, :], w_mod, b_mod)
    shift_c, scale_c, gate_c = modulation(c_ctx[None, :], w_mod, b_mod)
    q_a, k_a, v_a, g_a, q_b, k_b, v_b, g_b = even_heads(
        modulate(x, shift, scale) @ w_in, a_q_norm, a_kv_norm, a_w_uq, a_w_ukv, b_q_norm, b_k_norm, rope)
    q_ac, k_ac, v_ac, g_ac, q_bc, k_bc, v_bc, g_bc = even_heads(
        modulate(xc, shift_c, scale_c) @ w_in, a_q_norm, a_kv_norm, a_w_uq, a_w_ukv, b_q_norm, b_k_norm, None)
    y = attend_and_merge(q_a, jnp.concatenate([k_ac, k_a], axis=1), jnp.concatenate([v_ac, v_a], axis=1),
                         q_b, jnp.concatenate([k_bc, k_b], axis=1), jnp.concatenate([v_bc, v_b], axis=1),
                         g_a, g_b, w_out)
    x_new = layer_norm(DEEPNORM_ALPHA * x + gate * y, ln_g, ln_b)
    if update_ctx:
        yc = attend_and_merge(q_ac, k_ac, v_ac, q_bc, k_bc, v_bc, g_ac, g_bc, w_out)
        xc = layer_norm(DEEPNORM_ALPHA * xc + gate_c * yc, ln_g, ln_b)
    return x_new, xc


def chunk_gmlp(h, v_ln_g, v_ln_b, w_s, b_s):
    bsz, n, _ = h.shape
    u, v, g = jnp.split(h, 3, axis=-1)
    u = jax.nn.gelu(u)
    v = layer_norm(jax.nn.gelu(v), v_ln_g, v_ln_b)
    nc = n // C_CHUNK
    vv = v.reshape(bsz, nc, C_CHUNK, C_GROUPS, C_GROUP_W)
    mixed = jnp.einsum('gpq,bnqgc->bnpgc', w_s, vv) + b_s.T[None, None, :, :, None]
    return u * mixed.reshape(bsz, n, C_WIDTH) * jax.nn.silu(g)


def odd_layer(x, xc, c, c_ctx, w_mod, b_mod, w_in, v_ln_g, v_ln_b, w_s, b_s, w_out,
              ln_g, ln_b, update_ctx):
    shift, scale, gate = modulation(c[:, None, :], w_mod, b_mod)
    y = chunk_gmlp(modulate(x, shift, scale) @ w_in, v_ln_g, v_ln_b, w_s, b_s) @ w_out
    x_new = layer_norm(DEEPNORM_ALPHA * x + gate * y, ln_g, ln_b)
    if update_ctx:
        shift_c, scale_c, gate_c = modulation(c_ctx[None, :], w_mod, b_mod)
        yc = chunk_gmlp(modulate(xc, shift_c, scale_c) @ w_in, v_ln_g, v_ln_b, w_s, b_s) @ w_out
        xc = layer_norm(DEEPNORM_ALPHA * xc + gate_c * yc, ln_g, ln_b)
    return x_new, xc


def setup_inputs(seed: int = 0) -> dict:
    key = jax.random.key(seed)
    ks = iter(jax.random.split(key, 32))
    D = D_MODEL

    def nrm(shape, scale):
        return jax.random.normal(next(ks), shape, jnp.float32) * scale

    def gain(shape):
        return 1.0 + nrm(shape, 0.05)

    return {
        'x': nrm((BATCH, SEQ, D), 1.0),
        'c': nrm((BATCH, D), 1.0),
        'ctx': nrm((BATCH, CTX_LEN, D), 1.0),
        'c_ctx': nrm((D,), 1.0),
        'e_w_mod': nrm((N_EVEN, D, 3 * D), D ** -0.5),
        'e_b_mod': nrm((N_EVEN, 3 * D), 0.02),
        'e_w_in': nrm((N_EVEN, D, EVEN_IN), D ** -0.5),
        'e_a_q_norm': gain((N_EVEN, A_Q_RANK)),
        'e_a_kv_norm': gain((N_EVEN, A_KV_RANK)),
        'e_a_w_uq': nrm((N_EVEN, A_Q_RANK, A_HEADS * (A_NOPE + A_ROPE)), A_Q_RANK ** -0.5),
        'e_a_w_ukv': nrm((N_EVEN, A_KV_RANK, A_HEADS * (A_NOPE + A_V)), A_KV_RANK ** -0.5),
        'e_b_q_norm': gain((N_EVEN, B_HD)),
        'e_b_k_norm': gain((N_EVEN, B_HD)),
        'e_w_out': nrm((N_EVEN, EVEN_WIDTH, D), EVEN_WIDTH ** -0.5 * DEEPNORM_BETA),
        'e_ln_g': gain((N_EVEN, D)),
        'e_ln_b': nrm((N_EVEN, D), 0.02),
        'o_w_mod': nrm((N_ODD, D, 3 * D), D ** -0.5),
        'o_b_mod': nrm((N_ODD, 3 * D), 0.02),
        'o_w_in': nrm((N_ODD, D, ODD_IN), D ** -0.5),
        'o_v_ln_g': gain((N_ODD, C_WIDTH)),
        'o_v_ln_b': nrm((N_ODD, C_WIDTH), 0.02),
        'o_w_s': nrm((N_ODD, C_GROUPS, C_CHUNK, C_CHUNK), C_CHUNK ** -0.5),
        'o_b_s': 1.0 + nrm((N_ODD, C_GROUPS, C_CHUNK), 0.02),
        'o_w_out': nrm((N_ODD, C_WIDTH, D), C_WIDTH ** -0.5 * DEEPNORM_BETA),
        'o_ln_g': gain((N_ODD, D)),
        'o_ln_b': nrm((N_ODD, D), 0.02),
    }


def reference(x, c, ctx, c_ctx, e_w_mod, e_b_mod, e_w_in, e_a_q_norm, e_a_kv_norm, e_a_w_uq,
              e_a_w_ukv, e_b_q_norm, e_b_k_norm, e_w_out, e_ln_g, e_ln_b, o_w_mod, o_b_mod,
              o_w_in, o_v_ln_g, o_v_ln_b, o_w_s, o_b_s, o_w_out, o_ln_g, o_ln_b):
    xl, xc = x, ctx
    for i in range(DEPTH):
        update_ctx = any(j % 2 == 0 for j in range(i + 1, DEPTH))
        k = i // 2
        if i % 2 == 0:
            xl, xc = even_layer(xl, xc, c, c_ctx, e_w_mod[k], e_b_mod[k], e_w_in[k], e_a_q_norm[k],
                                e_a_kv_norm[k], e_a_w_uq[k], e_a_w_ukv[k], e_b_q_norm[k], e_b_k_norm[k],
                                e_w_out[k], e_ln_g[k], e_ln_b[k], update_ctx)
        else:
            xl, xc = odd_layer(xl, xc, c, c_ctx, o_w_mod[k], o_b_mod[k], o_w_in[k], o_v_ln_g[k],
                               o_v_ln_b[k], o_w_s[k], o_b_s[k], o_w_out[k], o_ln_g[k], o_ln_b[k],
                               update_ctx)
    return xl
```

```cpp
#include <hip/hip_runtime.h>
#include <hip/hip_cooperative_groups.h>
#include <cstdio>
namespace cg = cooperative_groups;

typedef unsigned short u16;
typedef short bf16x8 __attribute__((ext_vector_type(8)));
typedef short s16x4 __attribute__((ext_vector_type(4)));
typedef float f32x16 __attribute__((ext_vector_type(16)));
typedef __bf16 bf2_t __attribute__((ext_vector_type(2)));
typedef float f2_t __attribute__((ext_vector_type(2)));
typedef __attribute__((address_space(3))) s16x4 lds_s16x4;
typedef unsigned u32x4 __attribute__((ext_vector_type(4)));
typedef float f32x4 __attribute__((ext_vector_type(4)));
typedef unsigned u32x2 __attribute__((ext_vector_type(2)));

#define DI __device__ __forceinline__
#define MFMA(a, b, c) __builtin_amdgcn_mfma_f32_32x32x16_bf16((a), (b), (c), 0, 0, 0)

#define NLAT 32768
#define NCTX 1024
#define NTOK 33792
#define DM 1024
#define SEQ 8192
#define CTXL 256
#define TKV 8448
#define HSTR 2560
#define EVEN_IN 2464
#define C_CQ 0
#define C_CKV 384
#define C_KR 640
#define C_GA 672
#define C_QB 1184
#define C_KB 1696
#define C_VB 1824
#define C_GB 1952
#define ALPHA 1.4142135623730951f
#define LN_EPS 1e-6f
#define LOG2E 1.4426950408889634f
#define A_QSCALE (0.10206207261596577f * LOG2E)
#define B_QSCALE (0.125f * LOG2E)

#define OFF_MODE   0u
#define OFF_MODC   49152u
#define OFF_MODO   61440u
#define OFF_STATS  131072u
#define OFF_WINE   (OFF_STATS + 262144u)
#define OFF_WUQ    (OFF_WINE + 2560u*1024u*2u)
#define OFF_WUKV   (OFF_WUQ + 768u*384u*2u)
#define OFF_WOUTE  (OFF_WUKV + 1024u*256u*2u)
#define OFF_WINO   (OFF_WOUTE + 1024u*1024u*2u)
#define OFF_WOUTO  (OFF_WINO + 3072u*1024u*2u)
#define OFF_WS     (OFF_WOUTO + 1024u*1024u*2u)
#define OFF_XM     (OFF_WS + 8u*128u*128u*2u)
#define OFF_H      (OFF_XM + 33792u*1024u*2u)
#define OFF_QA     (OFF_H + 32768u*3072u*2u)
#define OFF_KA     (OFF_QA + 4u*8u*8192u*96u*2u)
#define OFF_VA     (OFF_KA + 4u*8u*8448u*96u*2u)
#define OFF_QB     (OFF_VA + 4u*8u*8448u*64u*2u)
#define OFF_KB     (OFF_QB + 4u*8u*8192u*64u*2u)
#define OFF_VB     (OFF_KB + 4u*2u*8448u*64u*2u)
#define OFF_END    (OFF_VB + 4u*2u*8448u*64u*2u)

struct Params {
  const float *x, *c, *ctx, *c_ctx, *e_w_mod, *e_b_mod, *e_w_in, *e_a_q_norm, *e_a_kv_norm, *e_a_w_uq, *e_a_w_ukv,
      *e_b_q_norm, *e_b_k_norm, *e_w_out, *e_ln_g, *e_ln_b, *o_w_mod, *o_b_mod, *o_w_in, *o_v_ln_g, *o_v_ln_b, *o_w_s,
      *o_b_s, *o_w_out, *o_ln_g, *o_ln_b;
  float* out;
  char* ws;
  int phase_lo, phase_hi;
};

DI int tid_opaque() { int t = threadIdx.x; asm volatile("" : "+v"(t)); return t; }
DI u32x4 mk4(unsigned a, unsigned b, unsigned c, unsigned d) { u32x4 r = {a, b, c, d}; return r; }
DI u32x2 mk2(unsigned a, unsigned b) { u32x2 r = {a, b}; return r; }
DI unsigned pack2(float a, float b) { f2_t v = {a, b}; bf2_t r = __builtin_convertvector(v, bf2_t); return __builtin_bit_cast(unsigned, r); }
DI u16 f2bf(float a) { return (u16)(pack2(a, 0.f) & 0xffffu); }
DI float bf2f(u16 v) { return __uint_as_float(((unsigned)v) << 16); }
DI float bflo(unsigned v) { return __uint_as_float(v << 16); }
DI float bfhi(unsigned v) { return __uint_as_float(v & 0xffff0000u); }
DI int crow(int r, int hh) { return (r & 3) + 8 * (r >> 2) + 4 * hh; }
DI float silu_f(float x) { return x * __builtin_amdgcn_rcpf(1.f + __builtin_amdgcn_exp2f(-LOG2E * x)); }
DI float gelu_f(float x) {
  const float u2 = x * (1.5957691216057308f + 0.07135481627260815f * x * x);
  return x * __builtin_amdgcn_rcpf(1.f + __builtin_amdgcn_exp2f(-LOG2E * u2));
}
DI float wave_sum(float v) {
#pragma unroll
  for (int o = 32; o > 0; o >>= 1) v += __shfl_xor(v, o);
  return v;
}

#define GSTR 144
#define GSTAGE (2 * 128 * GSTR)
template <bool ROWSS, class Epi, int ABL = 0>
DI void gemm_tile(const u16* __restrict__ A, int lda, const u16* __restrict__ Bt, int ldb, int K, int m0, int n0, char* smem, Epi epi) {
  const int t = tid_opaque(), lane = t & 63, w = t >> 6, wm = w >> 1, wn = w & 1, l31 = lane & 31, hh = lane >> 5;
  float* sRow = (float*)(smem + 2 * GSTAGE);
  f32x16 acc[2][2];
#pragma unroll
  for (int i = 0; i < 2; ++i)
#pragma unroll
    for (int j = 0; j < 2; ++j)
#pragma unroll
      for (int r = 0; r < 16; ++r) acc[i][j][r] = 0.f;
  const int lrow = t >> 3, lkc = t & 7;
  const u16* gA = A + (size_t)(m0 + lrow) * lda + lkc * 8;
  const u16* gB = Bt + (size_t)(n0 + lrow) * ldb + lkc * 8;
  u32x4 ra[4], rb[4];
  float ss[4] = {0.f, 0.f, 0.f, 0.f};
#define G_LOAD(k0_) { _Pragma("unroll") for (int i = 0; i < 4; ++i) { \
      ra[i] = *(const u32x4*)(gA + (size_t)(32 * i) * lda + (k0_)); rb[i] = *(const u32x4*)(gB + (size_t)(32 * i) * ldb + (k0_)); } }
#define G_STORE(st_) { char* dA_ = smem + (st_) * GSTAGE; char* dB_ = dA_ + 128 * GSTR; _Pragma("unroll") for (int i = 0; i < 4; ++i) { \
      *(u32x4*)(dA_ + (lrow + 32 * i) * GSTR + lkc * 16) = ra[i]; *(u32x4*)(dB_ + (lrow + 32 * i) * GSTR + lkc * 16) = rb[i]; \
      if (ROWSS) { float a0 = bflo(ra[i].x), a1 = bfhi(ra[i].x), a2 = bflo(ra[i].y), a3 = bfhi(ra[i].y); \
        float a4 = bflo(ra[i].z), a5 = bfhi(ra[i].z), a6 = bflo(ra[i].w), a7 = bfhi(ra[i].w); \
        ss[i] += a0 * a0 + a1 * a1 + a2 * a2 + a3 * a3 + a4 * a4 + a5 * a5 + a6 * a6 + a7 * a7; } } }
  const int NK = K >> 6;
  if (!ROWSS) {
    u32x4 ra2[4], rb2[4];
#define G_LOAD2(k0_) { _Pragma("unroll") for (int i = 0; i < 4; ++i) { \
      ra2[i] = *(const u32x4*)(gA + (size_t)(32 * i) * lda + (k0_)); rb2[i] = *(const u32x4*)(gB + (size_t)(32 * i) * ldb + (k0_)); } }
#define G_STORE2(st_) { char* dA_ = smem + (st_) * GSTAGE; char* dB_ = dA_ + 128 * GSTR; _Pragma("unroll") for (int i = 0; i < 4; ++i) { \
      *(u32x4*)(dA_ + (lrow + 32 * i) * GSTR + lkc * 16) = ra2[i]; *(u32x4*)(dB_ + (lrow + 32 * i) * GSTR + lkc * 16) = rb2[i]; } }
#define G_COMPUTE(st_) { const char* cA = smem + (st_) * GSTAGE; const char* cB = cA + 128 * GSTR; \
      _Pragma("unroll") for (int s = 0; s < 4; ++s) { bf16x8 af[2], bf[2]; \
        _Pragma("unroll") for (int i = 0; i < 2; ++i) af[i] = *(const bf16x8*)(cA + (wm * 64 + i * 32 + l31) * GSTR + s * 32 + hh * 16); \
        _Pragma("unroll") for (int j = 0; j < 2; ++j) bf[j] = *(const bf16x8*)(cB + (wn * 64 + j * 32 + l31) * GSTR + s * 32 + hh * 16); \
        _Pragma("unroll") for (int i = 0; i < 2; ++i) _Pragma("unroll") for (int j = 0; j < 2; ++j) acc[i][j] = MFMA(af[i], bf[j], acc[i][j]); } }
    G_LOAD(0);
    __syncthreads();
    G_STORE(0);
    if (NK > 1) G_LOAD(64);
    if (NK > 2) G_LOAD2(128);
#pragma unroll 1
    for (int kt = 0; kt < NK; kt += 2) {
      __syncthreads();
      if (kt + 1 < NK) G_STORE(1);
      if (kt + 3 < NK) G_LOAD((kt + 3) * 64);
      G_COMPUTE(0);
      if (kt + 1 < NK) {
        __syncthreads();
        if (kt + 2 < NK) G_STORE2(0);
        if (kt + 4 < NK) G_LOAD2((kt + 4) * 64);
        G_COMPUTE(1);
      }
    }
#undef G_LOAD2
#undef G_STORE2
#undef G_COMPUTE
  } else {
  G_LOAD(0);
  __syncthreads();
  G_STORE(0);
  if (NK > 1) G_LOAD(64);
#pragma unroll 1
  for (int kt = 0; kt < NK; ++kt) {
    __syncthreads();
    const char* cA = smem + (kt & 1) * GSTAGE;
    const char* cB = cA + 128 * GSTR;
if (!ROWSS) {
      bf16x8 af[4][2], bf[4][2];
#pragma unroll
      for (int s = 0; s < 4; ++s) {
#pragma unroll
        for (int i = 0; i < 2; ++i) af[s][i] = *(const bf16x8*)(cA + (wm * 64 + i * 32 + l31) * GSTR + s * 32 + hh * 16);
#pragma unroll
        for (int j = 0; j < 2; ++j) bf[s][j] = *(const bf16x8*)(cB + (wn * 64 + j * 32 + l31) * GSTR + s * 32 + hh * 16);
      }
      if (ABL != 2) {
      if (kt + 1 < NK) G_STORE((kt + 1) & 1);
      if (kt + 2 < NK) G_LOAD((kt + 2) * 64);
      }
      __builtin_amdgcn_sched_barrier(0);
      if (ABL != 1) {
#pragma unroll
      for (int s = 0; s < 4; ++s)
#pragma unroll
        for (int i = 0; i < 2; ++i)
#pragma unroll
          for (int j = 0; j < 2; ++j) acc[i][j] = MFMA(af[s][i], bf[s][j], acc[i][j]);
      } else {
#pragma unroll
      for (int s = 0; s < 4; ++s)
#pragma unroll
        for (int i = 0; i < 2; ++i) asm volatile("" :: "v"(af[s][i]), "v"(bf[s][i]));
      }
    } else {
      if (kt + 1 < NK) G_STORE((kt + 1) & 1);
      if (kt + 2 < NK) G_LOAD((kt + 2) * 64);
#pragma unroll
      for (int s = 0; s < 4; ++s) {
        bf16x8 af[2], bf[2];
#pragma unroll
        for (int i = 0; i < 2; ++i) af[i] = *(const bf16x8*)(cA + (wm * 64 + i * 32 + l31) * GSTR + s * 32 + hh * 16);
#pragma unroll
        for (int j = 0; j < 2; ++j) bf[j] = *(const bf16x8*)(cB + (wn * 64 + j * 32 + l31) * GSTR + s * 32 + hh * 16);
#pragma unroll
        for (int i = 0; i < 2; ++i)
#pragma unroll
          for (int j = 0; j < 2; ++j) acc[i][j] = MFMA(af[i], bf[j], acc[i][j]);
      }
    }
  }
  }
#undef G_LOAD
#undef G_STORE
  if (ROWSS) {
#pragma unroll
    for (int i = 0; i < 4; ++i) {
      float v = ss[i];
      v += __shfl_xor(v, 1);
      v += __shfl_xor(v, 2);
      v += __shfl_xor(v, 4);
      if (lkc == 0) sRow[lrow + 32 * i] = rsqrtf(v / (float)K + LN_EPS);
    }
    __syncthreads();
  }
  {
    float* sC = (float*)smem;
    __syncthreads();
#pragma unroll
    for (int i = 0; i < 2; ++i)
#pragma unroll
      for (int j = 0; j < 2; ++j)
#pragma unroll
        for (int r = 0; r < 16; ++r)
          sC[(wm * 64 + i * 32 + crow(r, hh)) * 132 + wn * 64 + j * 32 + l31] = acc[i][j][r];
    __syncthreads();
    epi.prep(m0, n0 + (t & 15) * 8);
#pragma unroll 1
    for (int it = 0; it < 8; ++it) {
      const int idx = t + 256 * it, pr = idx >> 4, cc = idx & 15;
      const f32x4 v0 = *(const f32x4*)(sC + pr * 132 + cc * 8), v1 = *(const f32x4*)(sC + pr * 132 + cc * 8 + 4);
      if (ROWSS) epi.row8s(m0 + pr, n0 + cc * 8, v0, v1, sC + pr * 132 + (cc ^ 1) * 8, sRow[pr]);
      else epi.row8(m0 + pr, n0 + cc * 8, v0, v1);
    }
  }
}

#define G2_BOFF (256 * GSTR)
template <class Epi>
DI void gemm_tile256(const u16* __restrict__ A, int lda, const u16* __restrict__ Bt, int ldb, int K, int m0, int n0, char* smem, Epi epi) {
  const int t = tid_opaque(), lane = t & 63, w = t >> 6, l31 = lane & 31, hh = lane >> 5;
  f32x16 acc[2][4];
#pragma unroll
  for (int i = 0; i < 2; ++i)
#pragma unroll
    for (int j = 0; j < 4; ++j)
#pragma unroll
      for (int r = 0; r < 16; ++r) acc[i][j][r] = 0.f;
  const int lrow = t >> 3, lkc = t & 7;
  const u16* gA = A + (size_t)(m0 + lrow) * lda + lkc * 8;
  const u16* gB = Bt + (size_t)(n0 + lrow) * ldb + lkc * 8;
  u32x4 ra[8], rb[4];
#pragma unroll
  for (int i = 0; i < 8; ++i) ra[i] = *(const u32x4*)(gA + (size_t)(32 * i) * lda);
#pragma unroll
  for (int i = 0; i < 4; ++i) rb[i] = *(const u32x4*)(gB + (size_t)(32 * i) * ldb);
  char* sA = smem;
  char* sB = smem + G2_BOFF;
#pragma unroll 1
  for (int k0 = 0; k0 < K; k0 += 64) {
    __syncthreads();
#pragma unroll
    for (int i = 0; i < 8; ++i) *(u32x4*)(sA + (lrow + 32 * i) * GSTR + lkc * 16) = ra[i];
#pragma unroll
    for (int i = 0; i < 4; ++i) *(u32x4*)(sB + (lrow + 32 * i) * GSTR + lkc * 16) = rb[i];
    __syncthreads();
    if (k0 + 64 < K) {
#pragma unroll
      for (int i = 0; i < 8; ++i) ra[i] = *(const u32x4*)(gA + (size_t)(32 * i) * lda + k0 + 64);
#pragma unroll
      for (int i = 0; i < 4; ++i) rb[i] = *(const u32x4*)(gB + (size_t)(32 * i) * ldb + k0 + 64);
    }
#pragma unroll
    for (int s = 0; s < 4; ++s) {
      bf16x8 af[2], bf[4];
#pragma unroll
      for (int i = 0; i < 2; ++i) af[i] = *(const bf16x8*)(sA + (w * 64 + i * 32 + l31) * GSTR + s * 32 + hh * 16);
#pragma unroll
      for (int j = 0; j < 4; ++j) bf[j] = *(const bf16x8*)(sB + (j * 32 + l31) * GSTR + s * 32 + hh * 16);
#pragma unroll
      for (int i = 0; i < 2; ++i)
#pragma unroll
        for (int j = 0; j < 4; ++j) acc[i][j] = MFMA(af[i], bf[j], acc[i][j]);
    }
  }
  float* sC = (float*)smem;
  epi.prep(m0, n0 + (t & 15) * 8);
#pragma unroll
  for (int half = 0; half < 2; ++half) {
    __syncthreads();
    if ((w >> 1) == half) {
#pragma unroll
      for (int i = 0; i < 2; ++i)
#pragma unroll
        for (int j = 0; j < 4; ++j)
#pragma unroll
          for (int r = 0; r < 16; ++r)
            sC[((w & 1) * 64 + i * 32 + crow(r, hh)) * 132 + j * 32 + l31] = acc[i][j][r];
    }
    __syncthreads();
#pragma unroll 1
    for (int it = 0; it < 8; ++it) {
      const int idx = t + 256 * it, pr = idx >> 4, cc = idx & 15;
      const f32x4 v0 = *(const f32x4*)(sC + pr * 132 + cc * 8), v1 = *(const f32x4*)(sC + pr * 132 + cc * 8 + 4);
      epi.row8(m0 + half * 128 + pr, n0 + cc * 8, v0, v1);
    }
  }
}

#define OPAQUE(ptr) asm volatile("" : "+v"(ptr))
struct EpiH {
  u16* H;
  DI void begin(int rbase, int col) { H += (size_t)rbase * HSTR + col; OPAQUE(H); }
  DI void elem(int ro, float v) const { H[ro * HSTR] = f2bf(v); }
  DI void row8(int row, int col, f32x4 a, f32x4 b) const {
    *(u32x4*)(H + (size_t)row * HSTR + col) = mk4(pack2(a.x, a.y), pack2(a.z, a.w), pack2(b.x, b.y), pack2(b.z, b.w));
  }
  DI void row8s(int, int, f32x4, f32x4, const float*, float) const {}
  DI void prep(int, int) {}
};
struct EpiQA {
  u16* QA;
  int s0, axis, lo8; bool isrope; float ifr;
  DI void begin(int rbase, int col) {
    const int b = rbase >> 13;
    s0 = rbase & 8191;
    const int head = col / 96, d = col - head * 96;
    QA += ((size_t)(b * 8 + head) * SEQ + s0) * 96 + d;
    OPAQUE(QA);
    isrope = ((col >> 5) % 3) == 2;
    const int i = col & 31, ii = i & 15;
    axis = i >> 4; lo8 = (ii < 8);
    ifr = exp2f(-13.287712379549449f * (float)(ii & 7) * 0.125f);
  }
  DI void elem(int ro, float v) const {
    v *= A_QSCALE;
    if (isrope) {
      const int s = s0 + ro;
      const float pos = (float)(axis ? (s & 63) : (s >> 6));
      const float ang = pos * ifr;
      const float cs = __cosf(ang), sn = __sinf(ang);
      const float pv = __shfl_xor(v, 8);
      v = lo8 ? (v * cs - pv * sn) : (v * cs + pv * sn);
    }
    QA[ro * 96] = f2bf(v);
  }
  DI void row8(int, int, f32x4, f32x4) const {}
  DI void prep(int, int) {}
  DI void row8s(int row, int col, f32x4 a, f32x4 b, const float* partner, float rs) const {
    const int bb = row >> 13, s = row & 8191;
    const int head = col / 96, d0 = col - head * 96;
    float v[8] = {a.x, a.y, a.z, a.w, b.x, b.y, b.z, b.w};
    const float sc = rs * A_QSCALE;
    if (d0 >= 64) {
      const f32x4 p0 = *(const f32x4*)partner, p1 = *(const f32x4*)(partner + 4);
      const float pv[8] = {p0.x, p0.y, p0.z, p0.w, p1.x, p1.y, p1.z, p1.w};
      const int i0 = d0 - 64;
      const float pos = (float)((i0 >> 4) ? (s & 63) : (s >> 6));
      const bool lo8 = (i0 & 8) == 0;
#pragma unroll
      for (int e = 0; e < 8; ++e) {
        const float ang = pos * exp2f(-13.287712379549449f * (float)e * 0.125f);
        const float cs = __cosf(ang), sn = __sinf(ang);
        v[e] = lo8 ? (v[e] * cs - pv[e] * sn) : (v[e] * cs + pv[e] * sn);
      }
    }
    *(u32x4*)(QA + ((size_t)(bb * 8 + head) * SEQ + s) * 96 + d0) =
        mk4(pack2(v[0] * sc, v[1] * sc), pack2(v[2] * sc, v[3] * sc), pack2(v[4] * sc, v[5] * sc), pack2(v[6] * sc, v[7] * sc));
  }
};
struct EpiKVA {
  u16 *KA, *VA;
  bool isk;
  DI void begin(int rbase, int col) {
    int b, tk;
    if (rbase < NLAT) { b = rbase >> 13; tk = CTXL + (rbase & 8191); } else { const int r2 = rbase - NLAT; b = r2 >> 8; tk = r2 & 255; }
    const int head = col >> 7, d = col & 127;
    const size_t base = (size_t)(b * 8 + head) * TKV + tk;
    isk = d < 64;
    KA += base * 96 + (d & 63);
    VA += base * 64 + (d & 63);
    OPAQUE(KA); OPAQUE(VA);
  }
  DI void elem(int ro, float v) const {
    if (isk) KA[ro * 96] = f2bf(v); else VA[ro * 64] = f2bf(v);
  }
  DI void row8(int, int, f32x4, f32x4) const {}
  DI void prep(int, int) {}
  DI void row8s(int row, int col, f32x4 a, f32x4 b, const float*, float rs) const {
    int bb, tk;
    if (row < NLAT) { bb = row >> 13; tk = CTXL + (row & 8191); } else { const int r2 = row - NLAT; bb = r2 >> 8; tk = r2 & 255; }
    const int head = col >> 7, d0 = col & 127;
    const size_t base = (size_t)(bb * 8 + head) * TKV + tk;
    u16* dst = (d0 < 64) ? KA + base * 96 + d0 : VA + base * 64 + (d0 - 64);
    *(u32x4*)dst = mk4(pack2(a.x * rs, a.y * rs), pack2(a.z * rs, a.w * rs), pack2(b.x * rs, b.y * rs), pack2(b.z * rs, b.w * rs));
  }
};
struct EpiZ {
  const float* x; const float* modE; float* Z;
  float gate;
  DI void begin(int rbase, int col) {
    gate = modE[(rbase >> 13) * 3072 + 2048 + col];
    x += (size_t)rbase * DM + col; Z += (size_t)rbase * DM + col;
    OPAQUE(x); OPAQUE(Z);
  }
  DI void elem(int ro, float v) const { Z[ro * DM] = ALPHA * x[ro * DM] + gate * v; }
  f32x4 pg0, pg1;
  DI void prep(int row0, int col) {
    const float* gp = modE + (row0 >> 13) * 3072 + 2048 + col;
    pg0 = *(const f32x4*)gp; pg1 = *(const f32x4*)(gp + 4);
  }
  DI void row8(int row, int col, f32x4 a, f32x4 b) const {
    const size_t idx = (size_t)row * DM + col;
    const f32x4 x0 = *(const f32x4*)(x + idx), x1 = *(const f32x4*)(x + idx + 4);
    *(f32x4*)(Z + idx) = ALPHA * x0 + pg0 * a;
    *(f32x4*)(Z + idx + 4) = ALPHA * x1 + pg1 * b;
  }
  DI void row8s(int, int, f32x4, f32x4, const float*, float) const {}
};
struct EpiNull {
  u16* H2;
  DI void begin(int rbase, int col) { H2 += (size_t)rbase * 3072 + col; OPAQUE(H2); }
  DI void elem(int ro, float v) const { if (v == 12345.678f) H2[ro * 3072] = 0; }
  DI void row8(int row, int col, f32x4 a, f32x4 b) const { if (a.x == 12345.678f) H2[(size_t)row * 3072 + col] = 0; }
  DI void row8s(int, int, f32x4, f32x4, const float*, float) const {}
  DI void prep(int, int) {}
};
struct EpiH2 {
  u16* H2;
  bool isg;
  DI void begin(int rbase, int col) { isg = col < 2048; H2 += (size_t)rbase * 3072 + col; OPAQUE(H2); }
  DI void elem(int ro, float v) const { H2[ro * 3072] = f2bf(isg ? gelu_f(v) : silu_f(v)); }
  DI void row8(int row, int col, f32x4 a, f32x4 b) const {
    float r[8] = {a.x, a.y, a.z, a.w, b.x, b.y, b.z, b.w};
    if (col < 2048) {
#pragma unroll
      for (int e = 0; e < 8; ++e) r[e] = gelu_f(r[e]);
    } else {
#pragma unroll
      for (int e = 0; e < 8; ++e) r[e] = silu_f(r[e]);
    }
    *(u32x4*)(H2 + (size_t)row * 3072 + col) = mk4(pack2(r[0], r[1]), pack2(r[2], r[3]), pack2(r[4], r[5]), pack2(r[6], r[7]));
  }
  DI void row8s(int, int, f32x4, f32x4, const float*, float) const {}
  DI void prep(int, int) {}
};
struct EpiOut {
  float* Z; const float* stats; const float* lng; const float* lnb; const float* modO;
  float g, bb, gate;
  DI void begin(int rbase, int col) {
    g = lng[col]; bb = lnb[col]; gate = modO[(rbase >> 13) * 3072 + 2048 + col];
    Z += (size_t)rbase * DM + col; stats += (size_t)rbase * 2;
    OPAQUE(Z); OPAQUE(stats);
  }
  DI void elem(int ro, float v) const {
    const float mu = stats[ro * 2], rstd = stats[ro * 2 + 1];
    const float x1 = (Z[ro * DM] - mu) * rstd * g + bb;
    Z[ro * DM] = ALPHA * x1 + gate * v;
  }
  f32x4 pl0, pl1, pc0, pc1, pg0, pg1;
  DI void prep(int row0, int col) {
    const float* gp = modO + (row0 >> 13) * 3072 + 2048 + col;
    pl0 = *(const f32x4*)(lng + col); pl1 = *(const f32x4*)(lng + col + 4);
    pc0 = *(const f32x4*)(lnb + col); pc1 = *(const f32x4*)(lnb + col + 4);
    pg0 = *(const f32x4*)gp; pg1 = *(const f32x4*)(gp + 4);
  }
  DI void row8(int row, int col, f32x4 a, f32x4 b) const {
    const size_t idx = (size_t)row * DM + col;
    const float mu = stats[row * 2], rstd = stats[row * 2 + 1];
    const f32x4 z0 = *(const f32x4*)(Z + idx), z1 = *(const f32x4*)(Z + idx + 4);
    *(f32x4*)(Z + idx) = ALPHA * ((z0 - mu) * rstd * pl0 + pc0) + pg0 * a;
    *(f32x4*)(Z + idx + 4) = ALPHA * ((z1 - mu) * rstd * pl1 + pc1) + pg1 * b;
  }
  DI void row8s(int, int, f32x4, f32x4, const float*, float) const {}
};

DI void transpose_tile(const float* __restrict__ src, int K, int N, u16* __restrict__ dst, int tile_n, int tile_k, const float* gk, char* smem) {
  float* tl = (float*)smem;
  const int t = tid_opaque();
  __syncthreads();
#pragma unroll
  for (int i = 0; i < 16; ++i) {
    const int kk = i * 4 + (t >> 6), nn = t & 63;
    const int k = tile_k * 64 + kk, n = tile_n * 64 + nn;
    float v = (n < N) ? src[(size_t)k * N + n] : 0.f;
    if (gk) v *= gk[k];
    tl[kk * 65 + nn] = v;
  }
  __syncthreads();
  const int nn = t >> 2, ks = (t & 3) * 16;
  unsigned pk[8];
#pragma unroll
  for (int e = 0; e < 8; ++e) pk[e] = pack2(tl[(ks + 2 * e) * 65 + nn], tl[(ks + 2 * e + 1) * 65 + nn]);
  u16* d = dst + (size_t)(tile_n * 64 + nn) * K + tile_k * 64 + ks;
  *(u32x4*)d = mk4(pk[0], pk[1], pk[2], pk[3]);
  *(u32x4*)(d + 8) = mk4(pk[4], pk[5], pk[6], pk[7]);
}

DI void gemv_item(const Params& p, int item, char* smem) {
  const int layer = item / 96, col0 = (item % 96) * 32;
  const float* wmod = layer ? p.o_w_mod : p.e_w_mod;
  const float* bmod = layer ? p.o_b_mod : p.e_b_mod;
  float* sc = (float*)smem;
  float* red = sc + 5 * 1024;
  const int t = tid_opaque();
  __syncthreads();
  for (int i = t; i < 5 * 1024; i += 256) {
    const float cv = (i < 4096) ? p.c[i] : p.c_ctx[i - 4096];
    sc[i] = silu_f(cv);
  }
  __syncthreads();
  const int col = t & 31, kg = t >> 5;
  float a0 = 0.f, a1 = 0.f, a2 = 0.f, a3 = 0.f, a4 = 0.f;
  const float* wp = wmod + (size_t)(kg * 128) * 3072 + col0 + col;
#pragma unroll 8
  for (int k = 0; k < 128; ++k) {
    const float wv = wp[(size_t)k * 3072];
    const int kk = kg * 128 + k;
    a0 += sc[kk] * wv; a1 += sc[1024 + kk] * wv; a2 += sc[2048 + kk] * wv; a3 += sc[3072 + kk] * wv; a4 += sc[4096 + kk] * wv;
  }
  red[(kg * 5 + 0) * 32 + col] = a0; red[(kg * 5 + 1) * 32 + col] = a1; red[(kg * 5 + 2) * 32 + col] = a2;
  red[(kg * 5 + 3) * 32 + col] = a3; red[(kg * 5 + 4) * 32 + col] = a4;
  __syncthreads();
  if (t < 160) {
    const int v = t >> 5, cc = t & 31;
    float s = 0.f;
#pragma unroll
    for (int g = 0; g < 8; ++g) s += red[(g * 5 + v) * 32 + cc];
    s += bmod[col0 + cc];
    float* modE = (float*)(p.ws + OFF_MODE);
    float* modC = (float*)(p.ws + OFF_MODC);
    float* modO = (float*)(p.ws + OFF_MODO);
    if (layer == 0) { if (v < 4) modE[v * 3072 + col0 + cc] = s; else modC[col0 + cc] = s; }
    else { if (v < 4) modO[v * 3072 + col0 + cc] = s; }
  }
}

DI void phase0(const Params& p, char* smem) {
  const int NI = 192 + 640 + 72 + 64 + 256 + 768 + 256 + 32;
  for (int it = blockIdx.x; it < NI; it += gridDim.x) {
    int i = it;
    if (i < 192) { gemv_item(p, i, smem); continue; }
    i -= 192;
    if (i < 640) { transpose_tile(p.e_w_in, 1024, EVEN_IN, (u16*)(p.ws + OFF_WINE), i / 16, i % 16, nullptr, smem); continue; }
    i -= 640;
    if (i < 72) { transpose_tile(p.e_a_w_uq, 384, 768, (u16*)(p.ws + OFF_WUQ), i / 6, i % 6, p.e_a_q_norm, smem); continue; }
    i -= 72;
    if (i < 64) { transpose_tile(p.e_a_w_ukv, 256, 1024, (u16*)(p.ws + OFF_WUKV), i / 4, i % 4, p.e_a_kv_norm, smem); continue; }
    i -= 64;
    if (i < 256) { transpose_tile(p.e_w_out, 1024, 1024, (u16*)(p.ws + OFF_WOUTE), i / 16, i % 16, nullptr, smem); continue; }
    i -= 256;
    if (i < 768) { transpose_tile(p.o_w_in, 1024, 3072, (u16*)(p.ws + OFF_WINO), i / 16, i % 16, nullptr, smem); continue; }
    i -= 768;
    if (i < 256) { transpose_tile(p.o_w_out, 1024, 1024, (u16*)(p.ws + OFF_WOUTO), i / 16, i % 16, nullptr, smem); continue; }
    i -= 256;
    {
      u16* dst = (u16*)(p.ws + OFF_WS);
      const int base = i * 4096 + tid_opaque() * 16;
#pragma unroll
      for (int e = 0; e < 16; e += 2) *(unsigned*)(dst + base + e) = pack2(p.o_w_s[base + e], p.o_w_s[base + e + 1]);
    }
  }
}

DI void phase1(const Params& p) {
  const float* modE = (const float*)(p.ws + OFF_MODE);
  const float* modC = (const float*)(p.ws + OFF_MODC);
  u16* XM = (u16*)(p.ws + OFF_XM);
  const size_t total = (size_t)NTOK * 128;
  for (size_t g = (size_t)blockIdx.x * 256 + tid_opaque(); g < total; g += (size_t)gridDim.x * 256) {
    const int row = (int)(g >> 7), k = (int)(g & 127) * 8;
    const float* src; const float* md;
    if (row < NLAT) { src = p.x + (size_t)row * DM; md = modE + (row >> 13) * 3072; }
    else { src = p.ctx + (size_t)(row - NLAT) * DM; md = modC; }
    const f32x4 x0 = *(const f32x4*)(src + k), x1 = *(const f32x4*)(src + k + 4);
    const f32x4 sh0 = *(const f32x4*)(md + k), sh1 = *(const f32x4*)(md + k + 4);
    const f32x4 s0 = *(const f32x4*)(md + 1024 + k), s1 = *(const f32x4*)(md + 1024 + k + 4);
    u32x4 o;
    o.x = pack2(x0.x * (1.f + s0.x) + sh0.x, x0.y * (1.f + s0.y) + sh0.y);
    o.y = pack2(x0.z * (1.f + s0.z) + sh0.z, x0.w * (1.f + s0.w) + sh0.w);
    o.z = pack2(x1.x * (1.f + s1.x) + sh1.x, x1.y * (1.f + s1.y) + sh1.y);
    o.w = pack2(x1.z * (1.f + s1.z) + sh1.z, x1.w * (1.f + s1.w) + sh1.w);
    *(u32x4*)(XM + (size_t)row * DM + k) = o;
  }
}

DI void unpack8(u32x4 r, float (&x)[8]) {
  x[0] = bflo(r.x); x[1] = bfhi(r.x); x[2] = bflo(r.y); x[3] = bfhi(r.y); x[4] = bflo(r.z); x[5] = bfhi(r.z); x[6] = bflo(r.w); x[7] = bfhi(r.w);
}
DI u32x4 pack8(const float (&x)[8]) { return mk4(pack2(x[0], x[1]), pack2(x[2], x[3]), pack2(x[4], x[5]), pack2(x[6], x[7])); }
DI void phase3_elem(const Params& p) {
  const u16* H = (const u16*)(p.ws + OFF_H);
  u16* KA = (u16*)(p.ws + OFF_KA);
  u16* QB = (u16*)(p.ws + OFF_QB);
  u16* KB = (u16*)(p.ws + OFF_KB);
  u16* VB = (u16*)(p.ws + OFF_VB);
  const int t = tid_opaque(), lane = t & 63;
  const int gw = blockIdx.x * 4 + (t >> 6), nw = gridDim.x * 4;
  const int hdA = lane >> 3, d0 = (lane & 7) * 8;
  const bool axB = ((lane & 7) >> 2) != 0, loB = (lane & 2) == 0;
  const int fi0 = (lane & 1) * 8;
  float ifB[8], ifA[8], gq[8], gk[8];
#pragma unroll
  for (int e = 0; e < 8; ++e) {
    ifB[e] = exp2f(-13.287712379549449f * (float)(fi0 + e) * 0.0625f);
    ifA[e] = exp2f(-13.287712379549449f * (float)e * 0.125f);
    gq[e] = p.e_b_q_norm[d0 + e];
    gk[e] = p.e_b_k_norm[d0 + e];
  }
  const int l16 = lane & 15, hd2 = l16 >> 3, l4 = lane & 3;
  const bool isk = lane < 16;
  for (int row = gw; row < NTOK; row += nw) {
    int b, tk, sq; bool lat;
    if (row < NLAT) { b = row >> 13; sq = row & 8191; tk = CTXL + sq; lat = true; }
    else { const int r2 = row - NLAT; b = r2 >> 8; tk = r2 & 255; sq = 0; lat = false; }
    const u16* hr = H + (size_t)row * HSTR;
    const float posr = (float)(sq >> 6), posc = (float)(sq & 63);
    const float posB = axB ? posc : posr;
    const u32x4 rawq = *(const u32x4*)(hr + C_QB + lane * 8);
    const u32x4 rawk = *(const u32x4*)(hr + (isk ? C_KB : C_VB) + l16 * 8);
    const u32x4 rawr = *(const u32x4*)(hr + C_KR + l4 * 8);
    float csB[8], snB[8];
    if (lat) {
#pragma unroll
      for (int e = 0; e < 8; ++e) { const float ang = posB * ifB[e]; csB[e] = __cosf(ang); snB[e] = __sinf(ang); }
    }
    if (lat) {
      float x[8];
      unpack8(rawq, x);
      float ss = 0.f;
#pragma unroll
      for (int e = 0; e < 8; ++e) ss += x[e] * x[e];
      ss += __shfl_xor(ss, 1); ss += __shfl_xor(ss, 2); ss += __shfl_xor(ss, 4);
      const float rs = rsqrtf(ss * (1.f / 64.f) + LN_EPS);
#pragma unroll
      for (int e = 0; e < 8; ++e) x[e] = x[e] * rs * gq[e];
      float y[8];
#pragma unroll
      for (int e = 0; e < 8; ++e) {
        const float pv = __shfl_xor(x[e], 2);
        y[e] = (loB ? (x[e] * csB[e] - pv * snB[e]) : (x[e] * csB[e] + pv * snB[e])) * B_QSCALE;
      }
      *(u32x4*)(QB + ((size_t)(b * 8 + hdA) * SEQ + sq) * 64 + d0) = pack8(y);
    }
    {
      float x[8];
      unpack8(rawk, x);
      float ss = 0.f;
#pragma unroll
      for (int e = 0; e < 8; ++e) ss += x[e] * x[e];
      ss += __shfl_xor(ss, 1); ss += __shfl_xor(ss, 2); ss += __shfl_xor(ss, 4);
      const float rs = rsqrtf(ss * (1.f / 64.f) + LN_EPS);
#pragma unroll
      for (int e = 0; e < 8; ++e) x[e] = x[e] * rs * gk[e];
      if (lat) {
        float y[8];
#pragma unroll
        for (int e = 0; e < 8; ++e) {
          const float pv = __shfl_xor(x[e], 2);
          y[e] = loB ? (x[e] * csB[e] - pv * snB[e]) : (x[e] * csB[e] + pv * snB[e]);
        }
#pragma unroll
        for (int e = 0; e < 8; ++e) x[e] = y[e];
      }
      const u32x4 outv = isk ? pack8(x) : rawk;
      if (lane < 32) *(u32x4*)((isk ? KB : VB) + ((size_t)(b * 2 + hd2) * TKV + tk) * 64 + (l16 & 7) * 8) = outv;
    }
    {
      float x[8];
      unpack8(rawr, x);
      if (lat) {
        const float posA = (l4 >> 1) ? posc : posr;
        float y[8];
#pragma unroll
        for (int e = 0; e < 8; ++e) {
          const float ang = posA * ifA[e];
          const float cs = __cosf(ang), sn = __sinf(ang);
          const float pv = __shfl_xor(x[e], 1);
          y[e] = ((l4 & 1) == 0) ? (x[e] * cs - pv * sn) : (x[e] * cs + pv * sn);
        }
#pragma unroll
        for (int e = 0; e < 8; ++e) x[e] = y[e];
      }
      if (lane < 4) {
        const u32x4 outv = pack8(x);
#pragma unroll
        for (int h = 0; h < 8; ++h) *(u32x4*)(KA + ((size_t)(b * 8 + h) * TKV + tk) * 96 + 64 + l4 * 8) = outv;
      }
    }
  }
}

#ifdef TELE_CYC
__device__ float tele_cyc_out[4];
#endif
#define VSTR 192
#define ATT_THR 6.0f
typedef unsigned u32x2v __attribute__((ext_vector_type(2)));
DI float fmax2(float a, float b) { return __builtin_amdgcn_fmed3f(a, b, __builtin_inff()); }
DI f32x16 zero16() { f32x16 z; _Pragma("unroll") for (int r = 0; r < 16; ++r) z[r] = 0.f; return z; }
DI float half_max(float x) {
  const u32x2v r = __builtin_amdgcn_permlane32_swap(__float_as_uint(x), __float_as_uint(x), false, false);
  return fmaxf(__uint_as_float(r[0]), __uint_as_float(r[1]));
}
template <int DK>
struct AttnCtx {
  static constexpr int KSTR = DK * 2 + 16;
  static constexpr int CK = DK / 8;
  static constexpr int NKC = 64 * CK / 256;
  static constexpr int NKS = DK / 16;
  static constexpr int KBYTES = 64 * KSTR;
  static constexpr int VBYTES = 64 * VSTR;
  static constexpr int NT = TKV / 64;
};

#define SGB_MFMA 0x008
#define SGB_VALU 0x002
#define SGB_DSRD 0x100
#define FENCE() __builtin_amdgcn_sched_barrier(0)
DI void sm_quad(int r, const f32x16& c0, const f32x16& c1, f2_t& ps, unsigned (&pk)[16]) {
  f2_t e, f;
  e.x = __builtin_amdgcn_exp2f(c0[r]); e.y = __builtin_amdgcn_exp2f(c0[r + 1]);
  f.x = __builtin_amdgcn_exp2f(c1[r]); f.y = __builtin_amdgcn_exp2f(c1[r + 1]);
  ps += e;
  ps += f;
  pk[r >> 1] = pack2(e.x, e.y);
  pk[8 + (r >> 1)] = pack2(f.x, f.y);
  asm volatile("" : "+v"(pk[r >> 1]), "+v"(pk[8 + (r >> 1)]), "+v"(ps));
}
template <int DK, bool DOQK>
DI void attn_half1(const char* sKn, const bf16x8 (&qf)[DK / 16], const f32x16& c0, const f32x16& c1, f32x16& n0, f32x16& n1,
                   unsigned (&pk)[16], const f32x16& negm, float& lsum, int l31, int hh) {
  constexpr int KSTR = AttnCtx<DK>::KSTR;
  constexpr int NKS = DK / 16;
  f2_t ps = {0.f, 0.f};
  if (DOQK) {
    const char* kp0 = sKn + l31 * KSTR + hh * 16;
    const char* kp1 = kp0 + 32 * KSTR;
    bf16x8 ka = *(const bf16x8*)(kp0), kb = *(const bf16x8*)(kp1);
    FENCE();
#pragma unroll
    for (int ks = 0; ks < NKS; ++ks) {
      bf16x8 na = ka, nb = kb;
      if (ks + 1 < NKS) { na = *(const bf16x8*)(kp0 + (ks + 1) * 32); nb = *(const bf16x8*)(kp1 + (ks + 1) * 32); }
      n0 = MFMA(ka, qf[ks], ks == 0 ? negm : n0);
#pragma unroll
      for (int q = (2 * ks) * 4 / NKS; q < (2 * ks + 1) * 4 / NKS; ++q) sm_quad(2 * q, c0, c1, ps, pk);
      FENCE();
      n1 = MFMA(kb, qf[ks], ks == 0 ? negm : n1);
#pragma unroll
      for (int q = (2 * ks + 1) * 4 / NKS; q < (2 * ks + 2) * 4 / NKS; ++q) sm_quad(2 * q, c0, c1, ps, pk);
      FENCE();
      ka = na; kb = nb;
    }
  } else {
#pragma unroll
    for (int q = 0; q < 8; ++q) sm_quad(2 * q, c0, c1, ps, pk);
  }
  lsum += ps.x + ps.y;
  FENCE();
}
template <int DK, bool DOQK, bool FIXED>
DI void attn_half2(const char* sVc, const unsigned (&pk)[16], f32x16& n0, f32x16& n1,
                   f32x16 (&o)[2], f32x16& negm, float& mref, float& lsum, int l31, int hh, int i16, int g16) {
  const char* vb = sVc + (hh * 4 + (i16 >> 2)) * VSTR + (g16 * 16) * 2 + (i16 & 3) * 8;
  constexpr bool DOMAX = DOQK && !FIXED;
  float mx = DOMAX ? fmaxf(n0[0], n1[0]) : 0.f;
  s16x4 lo0 = __builtin_amdgcn_ds_read_tr16_b64_v4i16((lds_s16x4*)(vb));
  s16x4 hi0 = __builtin_amdgcn_ds_read_tr16_b64_v4i16((lds_s16x4*)(vb + 8 * VSTR));
  s16x4 lo1 = __builtin_amdgcn_ds_read_tr16_b64_v4i16((lds_s16x4*)(vb + 64));
  s16x4 hi1 = __builtin_amdgcn_ds_read_tr16_b64_v4i16((lds_s16x4*)(vb + 64 + 8 * VSTR));
  FENCE();
#pragma unroll
  for (int st = 0; st < 4; ++st) {
    s16x4 nlo0 = lo0, nhi0 = hi0, nlo1 = lo1, nhi1 = hi1;
    if (st + 1 < 4) {
      const char* vn = vb + (st + 1) * 16 * VSTR;
      nlo0 = __builtin_amdgcn_ds_read_tr16_b64_v4i16((lds_s16x4*)(vn));
      nhi0 = __builtin_amdgcn_ds_read_tr16_b64_v4i16((lds_s16x4*)(vn + 8 * VSTR));
      nlo1 = __builtin_amdgcn_ds_read_tr16_b64_v4i16((lds_s16x4*)(vn + 64));
      nhi1 = __builtin_amdgcn_ds_read_tr16_b64_v4i16((lds_s16x4*)(vn + 64 + 8 * VSTR));
    }
    const bf16x8 pf = __builtin_bit_cast(bf16x8, mk4(pk[st * 4], pk[st * 4 + 1], pk[st * 4 + 2], pk[st * 4 + 3]));
    o[0] = MFMA(__builtin_shufflevector(lo0, hi0, 0, 1, 2, 3, 4, 5, 6, 7), pf, o[0]);
    if (DOMAX) {
#pragma unroll
      for (int r = 4 * st; r < 4 * st + 2; ++r) if (r > 0) asm volatile("v_max3_f32 %0, %0, %1, %2" : "+v"(mx) : "v"(n0[r]), "v"(n1[r]));
    }
    FENCE();
    o[1] = MFMA(__builtin_shufflevector(lo1, hi1, 0, 1, 2, 3, 4, 5, 6, 7), pf, o[1]);
    if (DOMAX) {
#pragma unroll
      for (int r = 4 * st + 2; r < 4 * st + 4; ++r) asm volatile("v_max3_f32 %0, %0, %1, %2" : "+v"(mx) : "v"(n0[r]), "v"(n1[r]));
    }
    FENCE();
    lo0 = nlo0; hi0 = nhi0; lo1 = nlo1; hi1 = nhi1;
  }
  if (DOMAX) {
    mx = half_max(mx);
    if (__any(mx > ATT_THR)) {
      const float d = fmaxf(mx, 0.f);
      const float alpha = __builtin_amdgcn_exp2f(-d);
      lsum *= alpha;
      mref += d;
      {
        float guard = o[0][0] + o[1][0] + n0[0] + n1[0] + negm[0];
        asm volatile("" :: "v"(guard));
      }
#pragma unroll
      for (int r = 0; r < 16; ++r) {
        asm volatile("v_mul_f32 %0, %0, %1" : "+v"(o[0][r]) : "v"(alpha));
        asm volatile("v_mul_f32 %0, %0, %1" : "+v"(o[1][r]) : "v"(alpha));
        asm volatile("v_sub_f32 %0, %0, %1" : "+v"(n0[r]) : "v"(d));
        asm volatile("v_sub_f32 %0, %0, %1" : "+v"(n1[r]) : "v"(d));
        asm volatile("v_sub_f32 %0, %0, %1" : "+v"(negm[r]) : "v"(d));
      }
    }
  }
}

template <int DK, int ABL = 0, bool FIXED = false>
DI void attn_item(const u16* __restrict__ Qg, const u16* __restrict__ Kg, const u16* __restrict__ Vg,
                  const u16* __restrict__ gate, u16* __restrict__ outp, int qblk, char* smem, float bound = 0.f) {
  typedef AttnCtx<DK> C;
  constexpr int KSTR = C::KSTR, CK = C::CK, NKC = C::NKC, NKS = C::NKS, NT = C::NT;
  const int t = tid_opaque(), lane = t & 63, w = t >> 6, l31 = lane & 31, hh = lane >> 5;
  const int i16 = lane & 15, g16 = (lane >> 4) & 1;
  const int q0 = qblk * 128 + w * 32;
  char* sK0 = smem;
  char* sK1 = smem + C::KBYTES;
  char* sV0 = smem + 2 * C::KBYTES;
  char* sV1 = sV0 + C::VBYTES;
  bf16x8 qf[NKS];
#pragma unroll
  for (int ks = 0; ks < NKS; ++ks) qf[ks] = *(const bf16x8*)(Qg + (size_t)(q0 + l31) * DK + ks * 16 + hh * 8);
  f32x16 o[2], negm;
#pragma unroll
  for (int r = 0; r < 16; ++r) { o[0][r] = 0.f; o[1][r] = 0.f; negm[r] = FIXED ? -bound : 0.f; }
  float mref = FIXED ? bound : 0.f, lsum = 0.f;
  u32x4 rk[NKC], rv[2];
  int koff[NKC], ksoff[NKC];
#pragma unroll
  for (int i = 0; i < NKC; ++i) { const int c = t + 256 * i; const int kr = c / CK, kc = c - kr * CK; koff[i] = kr * DK + kc * 8; ksoff[i] = kr * KSTR + kc * 16; }
  const int voff = (t >> 3) * 64 + (t & 7) * 8, vsoff = (t >> 3) * VSTR + (t & 7) * 16;
#define LOADK(tile) { const u16* kp_ = Kg + (size_t)(tile) * 64 * DK; _Pragma("unroll") for (int i = 0; i < NKC; ++i) rk[i] = *(const u32x4*)(kp_ + koff[i]); }
#define LOADV(tile) { const u16* vp_ = Vg + (size_t)(tile) * 64 * 64; rv[0] = *(const u32x4*)(vp_ + voff); rv[1] = *(const u32x4*)(vp_ + voff + 32 * 64); }
#define STOREK(dst) { _Pragma("unroll") for (int i = 0; i < NKC; ++i) *(u32x4*)((dst) + ksoff[i]) = rk[i]; }
#define STOREV(dst) { *(u32x4*)((dst) + vsoff) = rv[0]; *(u32x4*)((dst) + vsoff + 32 * VSTR) = rv[1]; }
  __syncthreads();
  LOADK(0); LOADV(0);
  STOREK(sK0); STOREV(sV0);
  LOADK(1);
  STOREK(sK1);
  LOADK(2); LOADV(1);
  __syncthreads();
  f32x16 a0, a1, b0, b1;
  {
#pragma unroll
    for (int ks = 0; ks < NKS; ++ks) {
      const bf16x8 k0 = *(const bf16x8*)(sK0 + l31 * KSTR + ks * 32 + hh * 16);
      const bf16x8 k1 = *(const bf16x8*)(sK0 + (32 + l31) * KSTR + ks * 32 + hh * 16);
      a0 = MFMA(k0, qf[ks], ks == 0 ? negm : a0);
      a1 = MFMA(k1, qf[ks], ks == 0 ? negm : a1);
    }
    if (!FIXED) {
      float mx = fmaxf(a0[0], a1[0]);
#pragma unroll
      for (int r = 1; r < 16; ++r) mx = fmaxf(mx, fmaxf(a0[r], a1[r]));
      mx = half_max(mx);
      mref = mx;
#pragma unroll
      for (int r = 0; r < 16; ++r) { a0[r] -= mx; a1[r] -= mx; negm[r] = -mx; }
    }
  }
#pragma unroll 1
  for (int j = 0; j + 4 < NT; j += 2) {
    unsigned pk[16];
    __syncthreads();
    STOREK(sK0);
    STOREV(sV1);
    attn_half1<DK, true>(sK1, qf, a0, a1, b0, b1, pk, negm, lsum, l31, hh);
    LOADK(j + 3);
    LOADV(j + 2);
    attn_half2<DK, true, FIXED>(sV0, pk, b0, b1, o, negm, mref, lsum, l31, hh, i16, g16);
    __syncthreads();
    STOREK(sK1);
    STOREV(sV0);
    attn_half1<DK, true>(sK0, qf, b0, b1, a0, a1, pk, negm, lsum, l31, hh);
    LOADK(j + 4);
    LOADV(j + 3);
    attn_half2<DK, true, FIXED>(sV1, pk, a0, a1, o, negm, mref, lsum, l31, hh, i16, g16);
  }
  {
    unsigned pk[16];
    constexpr int j = NT - 4;
    __syncthreads();
    STOREK(sK0);
    STOREV(sV1);
    attn_half1<DK, true>(sK1, qf, a0, a1, b0, b1, pk, negm, lsum, l31, hh);
    LOADK(j + 3);
    LOADV(j + 2);
    attn_half2<DK, true, FIXED>(sV0, pk, b0, b1, o, negm, mref, lsum, l31, hh, i16, g16);
    __syncthreads();
    STOREK(sK1);
    STOREV(sV0);
    attn_half1<DK, true>(sK0, qf, b0, b1, a0, a1, pk, negm, lsum, l31, hh);
    LOADV(j + 3);
    attn_half2<DK, true, FIXED>(sV1, pk, a0, a1, o, negm, mref, lsum, l31, hh, i16, g16);
    __syncthreads();
    STOREV(sV1);
    attn_half1<DK, true>(sK1, qf, a0, a1, b0, b1, pk, negm, lsum, l31, hh);
    attn_half2<DK, true, FIXED>(sV0, pk, b0, b1, o, negm, mref, lsum, l31, hh, i16, g16);
    __syncthreads();
    attn_half1<DK, false>(sK0, qf, b0, b1, a0, a1, pk, negm, lsum, l31, hh);
    attn_half2<DK, false, FIXED>(sV1, pk, a0, a1, o, negm, mref, lsum, l31, hh, i16, g16);
  }
#undef LOADK
#undef LOADV
#undef STOREK
#undef STOREV
  lsum += __shfl_xor(lsum, 32);
  const float inv = __builtin_amdgcn_rcpf(lsum);
  const size_t qrow = (size_t)(q0 + l31);
  u32x2 gv[2][4];
#pragma unroll
  for (int d = 0; d < 2; ++d)
#pragma unroll
    for (int g4 = 0; g4 < 4; ++g4) gv[d][g4] = *(const u32x2*)(gate + qrow * HSTR + d * 32 + g4 * 8 + hh * 4);
#pragma unroll
  for (int d = 0; d < 2; ++d)
#pragma unroll
    for (int g4 = 0; g4 < 4; ++g4) {
      const int dv0 = d * 32 + g4 * 8 + hh * 4;
      const float o0 = o[d][4 * g4 + 0] * inv * silu_f(bflo(gv[d][g4].x));
      const float o1 = o[d][4 * g4 + 1] * inv * silu_f(bfhi(gv[d][g4].x));
      const float o2 = o[d][4 * g4 + 2] * inv * silu_f(bflo(gv[d][g4].y));
      const float o3 = o[d][4 * g4 + 3] * inv * silu_f(bfhi(gv[d][g4].y));
      *(u32x2*)(outp + qrow * DM + dv0) = mk2(pack2(o0, o1), pack2(o2, o3));
    }
}

template <int ABL>
DI void phase4(const Params& p, char* smem) {
  const u16* H = (const u16*)(p.ws + OFF_H);
  u16* MG = ABL ? (u16*)(p.ws + OFF_END) : (u16*)(p.ws + OFF_XM);
  const u16* QA = (const u16*)(p.ws + OFF_QA);
  const u16* KA = (const u16*)(p.ws + OFF_KA);
  const u16* VA = (const u16*)(p.ws + OFF_VA);
  const u16* QB = (const u16*)(p.ws + OFF_QB);
  const u16* KB = (const u16*)(p.ws + OFF_KB);
  const u16* VB = (const u16*)(p.ws + OFF_VB);
  const int G = gridDim.x;
  const bool nice = (G % 128 == 0) && (4096 % G == 0);
  float gqm = 0.f, gkm = 0.f;
  for (int i = 0; i < 64; ++i) { gqm = fmaxf(gqm, fabsf(p.e_b_q_norm[i])); gkm = fmaxf(gkm, fabsf(p.e_b_k_norm[i])); }
  const float boundB = 64.f * gqm * gkm * B_QSCALE * 1.01f;
  const bool fixedB = boundB < 48.f;
  for (int v = blockIdx.x; v < 4096; v += G) {
    int type, hidx, qblk;
    if (nice) {
      const int round = v / G, bi = v - round * G;
      const int idx = (bi & 7) * (G >> 3) + (bi >> 3);
      const int xs = idx >> 6;
      qblk = idx & 63;
      type = (xs ^ round) & 1;
      hidx = round * (G >> 7) + (xs >> 1);
    } else {
      type = (v >> 6) & 1; hidx = v >> 7; qblk = v & 63;
    }
    const int b = hidx >> 3, head = hidx & 7;
    if (type == 0) {
      attn_item<96, ABL>(QA + (size_t)(b * 8 + head) * SEQ * 96, KA + (size_t)(b * 8 + head) * TKV * 96, VA + (size_t)(b * 8 + head) * TKV * 64,
                    H + (size_t)(b * SEQ) * HSTR + C_GA + head * 64, MG + (size_t)(ABL ? 0 : b * SEQ) * DM + head * 64, qblk, smem);
    } else {
      const int kvh = head >> 2;
      if (fixedB)
        attn_item<64, ABL, true>(QB + (size_t)(b * 8 + head) * SEQ * 64, KB + (size_t)(b * 2 + kvh) * TKV * 64, VB + (size_t)(b * 2 + kvh) * TKV * 64,
                    H + (size_t)(b * SEQ) * HSTR + C_GB + head * 64, MG + (size_t)(ABL ? 0 : b * SEQ) * DM + 512 + head * 64, qblk, smem, boundB);
      else
      attn_item<64, ABL>(QB + (size_t)(b * 8 + head) * SEQ * 64, KB + (size_t)(b * 2 + kvh) * TKV * 64, VB + (size_t)(b * 2 + kvh) * TKV * 64,
                    H + (size_t)(b * SEQ) * HSTR + C_GB + head * 64, MG + (size_t)(ABL ? 0 : b * SEQ) * DM + 512 + head * 64, qblk, smem);
    }
  }
}

DI void phase6(const Params& p) {
  const float* Z = p.out;
  float* stats = (float*)(p.ws + OFF_STATS);
  const float* modO = (const float*)(p.ws + OFF_MODO);
  u16* A1 = (u16*)(p.ws + OFF_XM);
  const int lane = tid_opaque() & 63;
  const int gw = blockIdx.x * 4 + (tid_opaque() >> 6), nw = gridDim.x * 4;
  for (int row = gw; row < NLAT; row += nw) {
    const float* zr = Z + (size_t)row * DM;
    f32x4 v[4];
#pragma unroll
    for (int i = 0; i < 4; ++i) v[i] = *(const f32x4*)(zr + i * 256 + lane * 4);
    float s = 0.f;
#pragma unroll
    for (int i = 0; i < 4; ++i) s += v[i].x + v[i].y + v[i].z + v[i].w;
    const float mu = wave_sum(s) * (1.f / 1024.f);
    float q = 0.f;
#pragma unroll
    for (int i = 0; i < 4; ++i) {
      const float a = v[i].x - mu, b = v[i].y - mu, c = v[i].z - mu, d = v[i].w - mu;
      q += a * a + b * b + c * c + d * d;
    }
    const float rstd = rsqrtf(wave_sum(q) * (1.f / 1024.f) + LN_EPS);
    if (lane == 0) { stats[row * 2] = mu; stats[row * 2 + 1] = rstd; }
    const float* md = modO + (row >> 13) * 3072;
#pragma unroll
    for (int i = 0; i < 4; ++i) {
      const int k = i * 256 + lane * 4;
      const f32x4 g = *(const f32x4*)(p.e_ln_g + k), bb = *(const f32x4*)(p.e_ln_b + k);
      const f32x4 sh = *(const f32x4*)(md + k), sc = *(const f32x4*)(md + 1024 + k);
      const float y0 = ((v[i].x - mu) * rstd * g.x + bb.x) * (1.f + sc.x) + sh.x;
      const float y1 = ((v[i].y - mu) * rstd * g.y + bb.y) * (1.f + sc.y) + sh.y;
      const float y2 = ((v[i].z - mu) * rstd * g.z + bb.z) * (1.f + sc.z) + sh.z;
      const float y3 = ((v[i].w - mu) * rstd * g.w + bb.w) * (1.f + sc.w) + sh.w;
      *(u32x2*)(A1 + (size_t)row * DM + k) = mk2(pack2(y0, y1), pack2(y2, y3));
    }
  }
}

#define MSTR 320
DI void phase8(const Params& p, char* smem) {
  const u16* H2 = (const u16*)(p.ws + OFF_H);
  const u16* WS = (const u16*)(p.ws + OFF_WS);
  u16* T = (u16*)(p.ws + OFF_XM);
  char* sA = smem;
  char* sB = smem + 128 * GSTR;
  float* sMix = (float*)smem;
  float* sMu = (float*)(smem + 128 * 132 * 4);
  float* sRs = sMu + 128;
  const int t = tid_opaque(), lane = t & 63, w = t >> 6, wm = w >> 1, wn = w & 1, l31 = lane & 31, hh = lane >> 5;
  const int i16 = lane & 15, g16 = (lane >> 4) & 1;
  for (int item = blockIdx.x; item < 512; item += gridDim.x) {
    const int ci = item >> 1, hf = item & 1;
    const int r0 = ci * 128;
    __syncthreads();
#pragma unroll 1
    for (int rr = 0; rr < 32; rr += 4) {
      float sv[4], qv[4];
#pragma unroll
      for (int u = 0; u < 4; ++u) {
        const u16* src = H2 + (size_t)(r0 + w * 32 + rr + u) * 3072 + 1024 + lane * 16;
        const u32x4 a = *(const u32x4*)src, b = *(const u32x4*)(src + 8);
        const float f[16] = {bflo(a.x), bfhi(a.x), bflo(a.y), bfhi(a.y), bflo(a.z), bfhi(a.z), bflo(a.w), bfhi(a.w),
                             bflo(b.x), bfhi(b.x), bflo(b.y), bfhi(b.y), bflo(b.z), bfhi(b.z), bflo(b.w), bfhi(b.w)};
        float s1 = 0.f, s2 = 0.f;
#pragma unroll
        for (int e = 0; e < 16; ++e) { s1 += f[e]; s2 += f[e] * f[e]; }
        sv[u] = s1; qv[u] = s2;
      }
#pragma unroll
      for (int o2 = 32; o2 > 0; o2 >>= 1) {
#pragma unroll
        for (int u = 0; u < 4; ++u) { sv[u] += __shfl_xor(sv[u], o2); qv[u] += __shfl_xor(qv[u], o2); }
      }
      if (lane == 0) {
#pragma unroll
        for (int u = 0; u < 4; ++u) {
          const float mu = sv[u] * (1.f / 1024.f);
          const float var = fmaxf(qv[u] * (1.f / 1024.f) - mu * mu, 0.f);
          sMu[w * 32 + rr + u] = mu; sRs[w * 32 + rr + u] = rsqrtf(var + LN_EPS);
        }
      }
    }
    __syncthreads();
#pragma unroll 1
    for (int gi = 0; gi < 4; ++gi) {
      const int g = hf * 4 + gi;
      f32x16 acc[2][2];
#pragma unroll
      for (int i = 0; i < 2; ++i)
#pragma unroll
        for (int j = 0; j < 2; ++j)
#pragma unroll
          for (int r = 0; r < 16; ++r) acc[i][j][r] = 0.f;
      const int chs = g * 128 + (t & 15) * 8;
      const f32x4 g0 = *(const f32x4*)(p.o_v_ln_g + chs), g1 = *(const f32x4*)(p.o_v_ln_g + chs + 4);
      const f32x4 b0 = *(const f32x4*)(p.o_v_ln_b + chs), b1 = *(const f32x4*)(p.o_v_ln_b + chs + 4);
#pragma unroll 1
      for (int kh = 0; kh < 2; ++kh) {
        __syncthreads();
        const u16* wsp = WS + (size_t)g * 16384 + kh * 64 + (t >> 3) * 128 + (t & 7) * 8;
#pragma unroll
        for (int i = 0; i < 4; ++i)
          *(u32x4*)(sA + ((t >> 3) + 32 * i) * GSTR + (t & 7) * 16) = *(const u32x4*)(wsp + i * 4096);
        const u16* hp = H2 + (size_t)(r0 + kh * 64 + (t >> 4)) * 3072 + 1024 + chs;
#pragma unroll 1
        for (int i = 0; i < 4; ++i) {
          const int row = (t >> 4) + 16 * i;
          const int ql = kh * 64 + row;
          const u32x4 raw = *(const u32x4*)(hp + (size_t)i * 16 * 3072);
          const float mu = sMu[ql], rs = sRs[ql];
          u32x4 o;
          o.x = pack2((bflo(raw.x) - mu) * rs * g0.x + b0.x, (bfhi(raw.x) - mu) * rs * g0.y + b0.y);
          o.y = pack2((bflo(raw.y) - mu) * rs * g0.z + b0.z, (bfhi(raw.y) - mu) * rs * g0.w + b0.w);
          o.z = pack2((bflo(raw.z) - mu) * rs * g1.x + b1.x, (bfhi(raw.z) - mu) * rs * g1.y + b1.y);
          o.w = pack2((bflo(raw.w) - mu) * rs * g1.z + b1.z, (bfhi(raw.w) - mu) * rs * g1.w + b1.w);
          *(u32x4*)(sB + row * MSTR + (t & 15) * 16) = o;
        }
        __syncthreads();
#pragma unroll
        for (int s = 0; s < 4; ++s) {
          bf16x8 af[2], bf[2];
#pragma unroll
          for (int i = 0; i < 2; ++i) af[i] = *(const bf16x8*)(sA + (wm * 64 + i * 32 + l31) * GSTR + s * 32 + hh * 16);
#pragma unroll
          for (int j = 0; j < 2; ++j) {
            const char* ba = sB + (s * 16 + hh * 8 + (i16 >> 2)) * MSTR + (wn * 64 + j * 32 + g16 * 16) * 2 + (i16 & 3) * 8;
            const s16x4 lo = __builtin_amdgcn_ds_read_tr16_b64_v4i16((lds_s16x4*)(ba));
            const s16x4 hi = __builtin_amdgcn_ds_read_tr16_b64_v4i16((lds_s16x4*)(ba + 4 * MSTR));
            bf[j] = __builtin_shufflevector(lo, hi, 0, 1, 2, 3, 4, 5, 6, 7);
          }
#pragma unroll
          for (int i = 0; i < 2; ++i)
#pragma unroll
            for (int j = 0; j < 2; ++j) acc[i][j] = MFMA(af[i], bf[j], acc[i][j]);
        }
      }
      __syncthreads();
#pragma unroll
      for (int i = 0; i < 2; ++i)
#pragma unroll
        for (int j = 0; j < 2; ++j)
#pragma unroll
          for (int r = 0; r < 16; ++r)
            sMix[(wm * 64 + i * 32 + crow(r, hh)) * 132 + wn * 64 + j * 32 + l31] = acc[i][j][r];
      __syncthreads();
#pragma unroll 1
      for (int it = 0; it < 8; ++it) {
        const int idx = t + 256 * it, pr = idx >> 4, cc = idx & 15;
        const u16* hrow = H2 + (size_t)(r0 + pr) * 3072 + g * 128 + cc * 8;
        const u32x4 uu = *(const u32x4*)hrow, gg = *(const u32x4*)(hrow + 2048);
        const float bs = p.o_b_s[g * 128 + pr];
        const f32x4 m0 = *(const f32x4*)(sMix + pr * 132 + cc * 8), m1 = *(const f32x4*)(sMix + pr * 132 + cc * 8 + 4);
        u32x4 o;
        o.x = pack2(bflo(uu.x) * (m0.x + bs) * bflo(gg.x), bfhi(uu.x) * (m0.y + bs) * bfhi(gg.x));
        o.y = pack2(bflo(uu.y) * (m0.z + bs) * bflo(gg.y), bfhi(uu.y) * (m0.w + bs) * bfhi(gg.y));
        o.z = pack2(bflo(uu.z) * (m1.x + bs) * bflo(gg.z), bfhi(uu.z) * (m1.y + bs) * bfhi(gg.z));
        o.w = pack2(bflo(uu.w) * (m1.z + bs) * bflo(gg.w), bfhi(uu.w) * (m1.w + bs) * bfhi(gg.w));
        *(u32x4*)(T + (size_t)(r0 + pr) * DM + g * 128 + cc * 8) = o;
      }
    }
  }
}

DI void phase10(const Params& p) {
  float* Z = p.out;
  const int lane = tid_opaque() & 63;
  const int gw = blockIdx.x * 4 + (tid_opaque() >> 6), nw = gridDim.x * 4;
  for (int row = gw; row < NLAT; row += nw) {
    float* zr = Z + (size_t)row * DM;
    f32x4 v[4];
#pragma unroll
    for (int i = 0; i < 4; ++i) v[i] = *(const f32x4*)(zr + i * 256 + lane * 4);
    float s = 0.f;
#pragma unroll
    for (int i = 0; i < 4; ++i) s += v[i].x + v[i].y + v[i].z + v[i].w;
    const float mu = wave_sum(s) * (1.f / 1024.f);
    float q = 0.f;
#pragma unroll
    for (int i = 0; i < 4; ++i) {
      const float a = v[i].x - mu, b = v[i].y - mu, c = v[i].z - mu, d = v[i].w - mu;
      q += a * a + b * b + c * c + d * d;
    }
    const float rstd = rsqrtf(wave_sum(q) * (1.f / 1024.f) + LN_EPS);
#pragma unroll
    for (int i = 0; i < 4; ++i) {
      const int k = i * 256 + lane * 4;
      const f32x4 g = *(const f32x4*)(p.o_ln_g + k), bb = *(const f32x4*)(p.o_ln_b + k);
      f32x4 y;
      y.x = (v[i].x - mu) * rstd * g.x + bb.x;
      y.y = (v[i].y - mu) * rstd * g.y + bb.y;
      y.z = (v[i].z - mu) * rstd * g.z + bb.z;
      y.w = (v[i].w - mu) * rstd * g.w + bb.w;
      *(f32x4*)(zr + k) = y;
    }
  }
}

#ifdef SELFCHECK
#define OFF_TELE (OFF_STATS - 256u)
DI float blk_max(float v, float* red) {
#pragma unroll
  for (int o = 32; o > 0; o >>= 1) v = fmaxf(v, __shfl_xor(v, o));
  __syncthreads();
  if ((tid_opaque() & 63) == 0) red[tid_opaque() >> 6] = v;
  __syncthreads();
  return fmaxf(fmaxf(red[0], red[1]), fmaxf(red[2], red[3]));
}
DI float blk_sum(float v, float* red) {
  v = wave_sum(v);
  __syncthreads();
  if ((tid_opaque() & 63) == 0) red[tid_opaque() >> 6] = v;
  __syncthreads();
  return red[0] + red[1] + red[2] + red[3];
}
DI void tele_max(const Params& p, int slot, float v) { atomicMax((unsigned*)(p.ws + OFF_TELE) + slot, __float_as_uint(v)); }

DI void check_attn(const Params& p, int s, char* smem) {
  float* sc = (float*)smem;
  float* red = sc + TKV;
  float* ored = red + 8;
  const int t = tid_opaque();
  const int type = s & 1, b = (s >> 1) & 3, head = (s >> 3) & 7, q = (s * 997 + 131 * head + 5) & 8191;
  const int DK = type ? 64 : 96;
  const u16* Q = type ? (const u16*)(p.ws + OFF_QB) + ((size_t)(b * 8 + head) * SEQ + q) * 64 : (const u16*)(p.ws + OFF_QA) + ((size_t)(b * 8 + head) * SEQ + q) * 96;
  const u16* K = type ? (const u16*)(p.ws + OFF_KB) + (size_t)(b * 2 + (head >> 2)) * TKV * 64 : (const u16*)(p.ws + OFF_KA) + (size_t)(b * 8 + head) * TKV * 96;
  const u16* V = type ? (const u16*)(p.ws + OFF_VB) + (size_t)(b * 2 + (head >> 2)) * TKV * 64 : (const u16*)(p.ws + OFF_VA) + (size_t)(b * 8 + head) * TKV * 64;
  const u16* H = (const u16*)(p.ws + OFF_H) + (size_t)(b * SEQ + q) * HSTR + (type ? C_GB : C_GA) + head * 64;
  const u16* MG = (const u16*)(p.ws + OFF_XM) + (size_t)(b * SEQ + q) * DM + (type ? 512 : 0) + head * 64;
  float mx = -1e30f;
  for (int key = t; key < TKV; key += 256) {
    float a = 0.f;
    for (int d = 0; d < DK; ++d) a += bf2f(Q[d]) * bf2f(K[(size_t)key * DK + d]);
    sc[key] = a; mx = fmaxf(mx, a);
  }
  mx = blk_max(mx, red);
  float ls = 0.f;
  for (int key = t; key < TKV; key += 256) { const float pp = exp2f(sc[key] - mx); sc[key] = pp; ls += pp; }
  ls = blk_sum(ls, red);
  __syncthreads();
  {
    const int dv = t & 63, part = t >> 6;
    float a = 0.f;
    for (int key = part; key < TKV; key += 4) a += sc[key] * bf2f(V[(size_t)key * 64 + dv]);
    ored[part * 64 + dv] = a;
  }
  __syncthreads();
  if (t < 64) {
    const float o = (ored[t] + ored[64 + t] + ored[128 + t] + ored[192 + t]) / ls;
    const float ex = o * silu_f(bf2f(H[t]));
    const float got = bf2f(MG[t]);
    float md = fabsf(ex - got), me = fabsf(ex);
#pragma unroll
    for (int o2 = 32; o2 > 0; o2 >>= 1) { md = fmaxf(md, __shfl_xor(md, o2)); me = fmaxf(me, __shfl_xor(me, o2)); }
    if (t == 0) tele_max(p, 0, md / (me + 1e-20f));
  }
  __syncthreads();
}

DI float rope_ref(float v, float partner, bool first, float pos, float invf) {
  const float ang = pos * invf;
  return first ? (v * cosf(ang) - partner * sinf(ang)) : (v * cosf(ang) + partner * sinf(ang));
}

DI void check_token(const Params& p, int row, char* smem) {
  float* xm = (float*)smem;
  float* hr = xm + 1024;
  float* nq = hr + 2464;
  float* nkv = nq + 384;
  float* qa = nkv + 256;
  float* kva = qa + 768;
  float* red = kva + 1024;
  float* dmax = red + 8;
  const int t = tid_opaque();
  const bool lat = row < NLAT;
  int b, sq, tk;
  if (lat) { b = row >> 13; sq = row & 8191; tk = CTXL + sq; } else { b = (row - NLAT) >> 8; tk = (row - NLAT) & 255; sq = 0; }
  __syncthreads();
  if (t < 2) ((unsigned*)dmax)[t] = 0u;
  const float* cv = lat ? p.c + b * 1024 : p.c_ctx;
  const float* src = lat ? p.x + (size_t)row * DM : p.ctx + (size_t)(row - NLAT) * DM;
  for (int k = t; k < 1024; k += 256) {
    float sh = p.e_b_mod[k], scl = p.e_b_mod[1024 + k];
    for (int j = 0; j < 1024; ++j) {
      const float sv = cv[j] / (1.f + expf(-cv[j]));
      sh += sv * p.e_w_mod[(size_t)j * 3072 + k];
      scl += sv * p.e_w_mod[(size_t)j * 3072 + 1024 + k];
    }
    xm[k] = src[k] * (1.f + scl) + sh;
  }
  __syncthreads();
  for (int col = t; col < EVEN_IN; col += 256) {
    float a = 0.f;
    for (int k = 0; k < 1024; ++k) a += xm[k] * p.e_w_in[(size_t)k * EVEN_IN + col];
    hr[col] = a;
  }
  __syncthreads();
  float s1 = 0.f, s2 = 0.f;
  for (int k = t; k < 384; k += 256) s1 += hr[C_CQ + k] * hr[C_CQ + k];
  for (int k = t; k < 256; k += 256) s2 += hr[C_CKV + k] * hr[C_CKV + k];
  s1 = blk_sum(s1, red);
  s2 = blk_sum(s2, red);
  const float rq = rsqrtf(s1 / 384.f + LN_EPS), rkv = rsqrtf(s2 / 256.f + LN_EPS);
  for (int k = t; k < 384; k += 256) nq[k] = hr[C_CQ + k] * rq * p.e_a_q_norm[k];
  for (int k = t; k < 256; k += 256) nkv[k] = hr[C_CKV + k] * rkv * p.e_a_kv_norm[k];
  __syncthreads();
  for (int col = t; col < 768; col += 256) { float a = 0.f; for (int k = 0; k < 384; ++k) a += nq[k] * p.e_a_w_uq[(size_t)k * 768 + col]; qa[col] = a; }
  for (int col = t; col < 1024; col += 256) { float a = 0.f; for (int k = 0; k < 256; ++k) a += nkv[k] * p.e_a_w_ukv[(size_t)k * 1024 + col]; kva[col] = a; }
  __syncthreads();
  const float posr = (float)(sq >> 6), posc = (float)(sq & 63);
  float md = 0.f, me = 0.f;
  for (int idx = t; idx < 8 * 96; idx += 256) {
    const int head = idx / 96, d = idx % 96;
    if (lat) {
      float v = qa[head * 96 + d];
      if (d >= 64) {
        const int i = d - 64, axis = i >> 4, ii = i & 15, fi = ii & 7;
        const float invf = powf(10000.f, -(float)(2 * fi) / 16.f);
        const float partner = qa[head * 96 + 64 + axis * 16 + (ii ^ 8)];
        v = rope_ref(v, partner, ii < 8, axis ? posc : posr, invf);
      }
      v *= A_QSCALE;
      const float got = bf2f(((const u16*)(p.ws + OFF_QA))[((size_t)(b * 8 + head) * SEQ + sq) * 96 + d]);
      md = fmaxf(md, fabsf(v - got)); me = fmaxf(me, fabsf(v));
    }
    {
      float v;
      if (d < 64) v = kva[head * 128 + d];
      else {
        const int i = d - 64, axis = i >> 4, ii = i & 15, fi = ii & 7;
        v = hr[C_KR + i];
        if (lat) {
          const float invf = powf(10000.f, -(float)(2 * fi) / 16.f);
          v = rope_ref(v, hr[C_KR + axis * 16 + (ii ^ 8)], ii < 8, axis ? posc : posr, invf);
        }
      }
      const float got = bf2f(((const u16*)(p.ws + OFF_KA))[((size_t)(b * 8 + head) * TKV + tk) * 96 + d]);
      md = fmaxf(md, fabsf(v - got)); me = fmaxf(me, fabsf(v));
    }
    if (d < 64) {
      const float v = kva[head * 128 + 64 + d];
      const float got = bf2f(((const u16*)(p.ws + OFF_VA))[((size_t)(b * 8 + head) * TKV + tk) * 64 + d]);
      md = fmaxf(md, fabsf(v - got)); me = fmaxf(me, fabsf(v));
    }
  }
  for (int idx = t; idx < 12 * 64; idx += 256) {
    const int hd = idx >> 6, d = idx & 63;
    const int axis = d >> 5, ii = d & 31, fi = ii & 15;
    const float invf = powf(10000.f, -(float)(2 * fi) / 32.f);
    if (hd < 8) {
      if (lat) {
        float ss = 0.f;
        for (int e = 0; e < 64; ++e) ss += hr[C_QB + hd * 64 + e] * hr[C_QB + hd * 64 + e];
        const float rr = rsqrtf(ss / 64.f + LN_EPS);
        float v = hr[C_QB + hd * 64 + d] * rr * p.e_b_q_norm[d];
        const int dp = axis * 32 + (ii ^ 16);
        const float partner = hr[C_QB + hd * 64 + dp] * rr * p.e_b_q_norm[dp];
        v = rope_ref(v, partner, ii < 16, axis ? posc : posr, invf) * B_QSCALE;
        const float got = bf2f(((const u16*)(p.ws + OFF_QB))[((size_t)(b * 8 + hd) * SEQ + sq) * 64 + d]);
        md = fmaxf(md, fabsf(v - got)); me = fmaxf(me, fabsf(v));
      }
    } else if (hd < 10) {
      const int kh = hd - 8;
      float ss = 0.f;
      for (int e = 0; e < 64; ++e) ss += hr[C_KB + kh * 64 + e] * hr[C_KB + kh * 64 + e];
      const float rr = rsqrtf(ss / 64.f + LN_EPS);
      float v = hr[C_KB + kh * 64 + d] * rr * p.e_b_k_norm[d];
      if (lat) {
        const int dp = axis * 32 + (ii ^ 16);
        const float partner = hr[C_KB + kh * 64 + dp] * rr * p.e_b_k_norm[dp];
        v = rope_ref(v, partner, ii < 16, axis ? posc : posr, invf);
      }
      const float got = bf2f(((const u16*)(p.ws + OFF_KB))[((size_t)(b * 2 + kh) * TKV + tk) * 64 + d]);
      md = fmaxf(md, fabsf(v - got)); me = fmaxf(me, fabsf(v));
    } else {
      const int kh = hd - 10;
      const float v = hr[C_VB + kh * 64 + d];
      const float got = bf2f(((const u16*)(p.ws + OFF_VB))[((size_t)(b * 2 + kh) * TKV + tk) * 64 + d]);
      md = fmaxf(md, fabsf(v - got)); me = fmaxf(me, fabsf(v));
    }
  }
  for (int idx = t; idx < 1024; idx += 256) {
    const int col = (idx < 512) ? C_GA + idx : C_GB + idx - 512;
    const float got = bf2f(((const u16*)(p.ws + OFF_H))[(size_t)row * HSTR + col]);
    md = fmaxf(md, fabsf(hr[col] - got)); me = fmaxf(me, fabsf(hr[col]));
  }
  md = blk_max(md, red);
  me = blk_max(me, red);
  if (t == 0) tele_max(p, 1, md / (me + 1e-20f));
  __syncthreads();
}

DI void check_merge_y(const Params& p, int s, char* smem) {
  float* mg = (float*)smem;
  float* red = mg + 1024;
  const int t = tid_opaque();
  const int row = (s * 4099 + 33) & 32767, b = row >> 13;
  __syncthreads();
  for (int k = t; k < 1024; k += 256) mg[k] = bf2f(((const u16*)(p.ws + OFF_XM))[(size_t)row * DM + k]);
  __syncthreads();
  float md = 0.f, me = 0.f;
  for (int col = t; col < 1024; col += 256) {
    float a = 0.f;
    for (int k = 0; k < 1024; ++k) a += mg[k] * p.e_w_out[(size_t)k * 1024 + col];
    const float gate = ((const float*)(p.ws + OFF_MODE))[b * 3072 + 2048 + col];
    const float got = (p.out[(size_t)row * DM + col] - ALPHA * p.x[(size_t)row * DM + col]);
    md = fmaxf(md, fabsf(gate * a - got)); me = fmaxf(me, fabsf(gate * a));
  }
  md = blk_max(md, red);
  me = blk_max(me, red);
  if (t == 0) tele_max(p, 2, md / (me + 1e-20f));
  __syncthreads();
}
DI float tele_digit(float x) { return x < 0.003f ? 1.f : x < 0.01f ? 2.f : x < 0.03f ? 3.f : x < 0.1f ? 4.f : x < 0.3f ? 5.f : x < 1.f ? 6.f : 7.f; }
#endif

#define OFF_BAR 110592u
#define XB_TMO      128
#define XB_XCNT(j)  (256  + 64 * (j))
#define XB_XSUB(j)  (1280 + 64 * (j))
#define XB_XGEN(j)  (2304 + 64 * (j))
#define XB_TOP      3328
#define XB_TOPGEN   3392
#define XCD_BAR_WORDS 3456
#define XB_SPIN_CAP (1u << 18)
#define LAS __attribute__((address_space(3)))
DI unsigned xb_ld(unsigned* p)              { return __hip_atomic_load(p, __ATOMIC_RELAXED, __HIP_MEMORY_SCOPE_AGENT); }
DI unsigned xb_add(unsigned* p, unsigned v) { return __hip_atomic_fetch_add(p, v, __ATOMIC_RELAXED, __HIP_MEMORY_SCOPE_AGENT); }
DI unsigned xb_xcc_id() { return (unsigned)__builtin_amdgcn_s_getreg((3 << 11) | 20) & 0xFu; }
#define XB_SPIN(cond, bar) do { unsigned _sp = 0; while (cond) { __builtin_amdgcn_s_sleep(1); \
    if ((++_sp & 255u) == 0u) { if (xb_ld(&(bar)[XB_TMO])) break; if (_sp > XB_SPIN_CAP) { atomicAdd(&(bar)[XB_TMO], 1u); break; } } } } while (0)
struct XcdBarrier { unsigned* bar; unsigned x; volatile LAS unsigned* st; };
DI XcdBarrier xcd_barrier_post(unsigned* bar, volatile LAS unsigned* st) {
  XcdBarrier b; b.bar = bar; b.x = xb_xcc_id(); b.st = st;
  if (tid_opaque() == 0) (void)xb_add(&bar[XB_XCNT(b.x)], 1u);
  return b;
}
DI void xcd_barrier_complete(unsigned* bar, unsigned x, unsigned& nloc, unsigned& nx) {
  const unsigned G = gridDim.x * gridDim.y * gridDim.z;
  unsigned sum, cnt, mine, sp = 0u;
  for (;;) {
    sum = 0u; cnt = 0u; mine = 0u;
#pragma unroll
    for (unsigned j = 0; j < 16; ++j) { const unsigned c = xb_ld(&bar[XB_XCNT(j)]); sum += c; cnt += (c > 0u) ? 1u : 0u; mine = (j == x) ? c : mine; }
    if (sum == G) break;
    __builtin_amdgcn_s_sleep(1);
    if ((++sp & 255u) == 0u) { if (xb_ld(&bar[XB_TMO])) break; if (sp > XB_SPIN_CAP) { atomicAdd(&bar[XB_TMO], 1u); break; } }
  }
  nloc = mine > 0u ? mine : 1u; nx = cnt > 0u ? cnt : 1u;
}
DI void xcd_barrier(const XcdBarrier& b) {
  asm volatile("s_waitcnt vmcnt(0)" ::: "memory");
  __syncthreads();
  if (tid_opaque() == 0) {
    unsigned* bar = b.bar;
    __builtin_amdgcn_s_waitcnt(0);
    unsigned nloc = b.st[0], nx = b.st[1];
    if (nloc == 0u) { xcd_barrier_complete(bar, b.x, nloc, nx); b.st[0] = nloc; b.st[1] = nx; }
    const unsigned old = xb_add(&bar[XB_XSUB(b.x)], 1u);
    const unsigned gen = old / nloc;
    if (old + 1u == (gen + 1u) * nloc) {
      __builtin_amdgcn_fence(__ATOMIC_RELEASE, "agent");
      asm volatile("s_waitcnt vmcnt(0)" ::: "memory");
      const unsigned og = xb_add(&bar[XB_TOP], 1u);
      const unsigned tg = og / nx;
      if (og + 1u == (tg + 1u) * nx) xb_add(&bar[XB_TOPGEN], 1u);
      else XB_SPIN(xb_ld(&bar[XB_TOPGEN]) == tg, bar);
      __builtin_amdgcn_fence(__ATOMIC_ACQUIRE, "agent");
      xb_add(&bar[XB_XGEN(b.x)], 1u);
      asm volatile("s_waitcnt vmcnt(0)" ::: "memory");
    } else {
      XB_SPIN(xb_ld(&bar[XB_XGEN(b.x)]) == gen, bar);
      __builtin_amdgcn_fence(__ATOMIC_ACQUIRE, "agent");
      asm volatile("s_waitcnt vmcnt(0)" ::: "memory");
    }
  }
  __syncthreads();
}

template <int SM, int SN>
DI bool tile_map(int it, int MT, int NTL, int& m, int& n) {
  const int x = blockIdx.x & 7, r = blockIdx.x >> 3;
  const int nsn = (NTL + SN - 1) / SN;
  const int S = it * 8 + x;
  const int sm = S / nsn, sn = S - sm * nsn;
  m = sm * SM + r / SN;
  n = sn * SN + r % SN;
  return (m < MT) && (n < NTL);
}
template <int SM, int SN>
DI int tile_iters(int MT, int NTL) { return (((MT + SM - 1) / SM) * ((NTL + SN - 1) / SN) + 7) / 8; }

#ifndef USE_T256
#define USE_T256 1
#endif
#define SMEM_BYTES (2 * GSTAGE + 512)
__global__ void __launch_bounds__(256, 2) fwd_megakernel(Params p) {
  extern __shared__ __attribute__((aligned(16))) char smem[];
  __shared__ __attribute__((aligned(16))) unsigned xb_words[4];
  cg::grid_group grid = cg::this_grid();
  const int G = gridDim.x;
  char* ws = p.ws;
  if (tid_opaque() < 4) xb_words[tid_opaque()] = 0u;
  __syncthreads();
#ifdef REP_PHASE
#define PH_REPS(n) (((n) == REP_PHASE) ? 2 : 1)
#else
#define PH_REPS(n) 1
#endif
#define PH_BEGIN(n) for (int rep_ = 0; rep_ < PH_REPS(n); ++rep_) { xcd_barrier(xb);
#define PH_END }
  const XcdBarrier xb = xcd_barrier_post((unsigned*)(ws + OFF_BAR), (volatile LAS unsigned*)&xb_words[0]);
  if (p.phase_lo == 0x7fffffff) grid.sync();
  for (int rep_ = 0; rep_ < PH_REPS(0); ++rep_) { if (rep_) xcd_barrier(xb);
    phase0(p, smem);
#ifdef SELFCHECK
    if (blockIdx.x == 0 && tid_opaque() < 8) ((unsigned*)(ws + OFF_TELE))[tid_opaque()] = 0u;
#endif
  }
  PH_BEGIN(1) phase1(p); PH_END
  PH_BEGIN(2) {
    const int NTN = 20, MTN = 264, NTILES = MTN * NTN;
    if (USE_T256 && G == 512) {
      for (int tI = blockIdx.x; tI < 128 * NTN; tI += G)
        gemm_tile256((const u16*)(ws + OFF_XM), DM, (const u16*)(ws + OFF_WINE), DM, DM, (tI / NTN) * 256, (tI % NTN) * 128, smem, EpiH{(u16*)(ws + OFF_H)});
      for (int tI = blockIdx.x; tI < 8 * NTN; tI += G)
        gemm_tile<false>((const u16*)(ws + OFF_XM), DM, (const u16*)(ws + OFF_WINE), DM, DM, NLAT + (tI / NTN) * 128, (tI % NTN) * 128, smem, EpiH{(u16*)(ws + OFF_H)});
    } else
    for (int tI = blockIdx.x; tI < NTILES; tI += G)
      gemm_tile<false>((const u16*)(ws + OFF_XM), DM, (const u16*)(ws + OFF_WINE), DM, DM, (tI / NTN) * 128, (tI % NTN) * 128, smem,
                       EpiH{(u16*)(ws + OFF_H)});
  } PH_END
  PH_BEGIN(3) {
    const int NQ = 256 * 6, NKV = 264 * 8;
    for (int tI = blockIdx.x; tI < NKV + NQ; tI += G) {
      if (tI < NKV)
        gemm_tile<true>((const u16*)(ws + OFF_H) + C_CKV, HSTR, (const u16*)(ws + OFF_WUKV), 256, 256, (tI / 8) * 128, (tI % 8) * 128, smem,
                        EpiKVA{(u16*)(ws + OFF_KA), (u16*)(ws + OFF_VA), false});
      else {
        const int u = tI - NKV;
        gemm_tile<true>((const u16*)(ws + OFF_H) + C_CQ, HSTR, (const u16*)(ws + OFF_WUQ), 384, 384, (u / 6) * 128, (u % 6) * 128, smem,
                        EpiQA{(u16*)(ws + OFF_QA), 0, 0, 0, false, 0.f});
      }
    }
    phase3_elem(p);
#ifdef REP_ELEM
    __syncthreads();
    phase3_elem(p);
#endif
  } PH_END
  PH_BEGIN(4) phase4<0>(p, smem); PH_END
#ifdef SHADOW4
  xcd_barrier(xb);
  phase4<SHADOW4>(p, smem);
#endif
#ifdef SELFCHECK
  grid.sync();
  for (int sI = blockIdx.x; sI < 128; sI += G) {
    if (sI < 64) check_attn(p, sI, smem);
    else { const int u = sI - 64; check_token(p, (u < 56) ? ((u * 5003 + 17) & 32767) : (NLAT + ((u * 131 + 7) & 1023)), smem); }
  }
#endif
  PH_BEGIN(5) {
    const int NTN = 8, MTN = 256, NTILES = MTN * NTN;
    if (USE_T256 && G == 512) {
      for (int tI = blockIdx.x; tI < 128 * NTN; tI += G)
        gemm_tile256((const u16*)(ws + OFF_XM), DM, (const u16*)(ws + OFF_WOUTE), DM, DM, (tI / NTN) * 256, (tI % NTN) * 128, smem,
                     EpiZ{p.x, (const float*)(ws + OFF_MODE), p.out, 0.f});
    } else
    for (int tI = blockIdx.x; tI < NTILES; tI += G)
      gemm_tile<false>((const u16*)(ws + OFF_XM), DM, (const u16*)(ws + OFF_WOUTE), DM, DM, (tI / NTN) * 128, (tI % NTN) * 128, smem,
                       EpiZ{p.x, (const float*)(ws + OFF_MODE), p.out, 0.f});
  } PH_END
#ifdef SELFCHECK
  grid.sync();
  for (int sI = blockIdx.x; sI < 32; sI += G) check_merge_y(p, sI, smem);
#endif
  PH_BEGIN(6) phase6(p); PH_END
  PH_BEGIN(7) {
    const int NTN = 24, MTN = 256, NTILES = MTN * NTN;
    if (USE_T256 && G == 512) {
      for (int tI = blockIdx.x; tI < 128 * NTN; tI += G)
        gemm_tile256((const u16*)(ws + OFF_XM), DM, (const u16*)(ws + OFF_WINO), DM, DM, (tI / NTN) * 256, (tI % NTN) * 128, smem, EpiH2{(u16*)(ws + OFF_H), false});
    } else
    for (int tI = blockIdx.x; tI < NTILES; tI += G)
      gemm_tile<false>((const u16*)(ws + OFF_XM), DM, (const u16*)(ws + OFF_WINO), DM, DM, (tI / NTN) * 128, (tI % NTN) * 128, smem,
                       EpiH2{(u16*)(ws + OFF_H), false});
  } PH_END
#ifdef SHADOW7
  xcd_barrier(xb);
  {
    const int NTN = 24, MTN = 256;
    for (int it = 0; it < tile_iters<8, 8>(MTN, NTN); ++it) { int tm, tn;
      if (tile_map<8, 8>(it, MTN, NTN, tm, tn))
        gemm_tile<false, EpiNull, SHADOW7>((const u16*)(ws + OFF_XM), DM, (const u16*)(ws + OFF_WINO), DM, DM, tm * 128, tn * 128, smem, EpiNull{(u16*)(ws + OFF_H)}); }
  }
#endif
  PH_BEGIN(8) phase8(p, smem); PH_END
  PH_BEGIN(9) {
    const int NTN = 8, MTN = 256, NTILES = MTN * NTN;
    if (USE_T256 && G == 512) {
      for (int tI = blockIdx.x; tI < 128 * NTN; tI += G)
        gemm_tile256((const u16*)(ws + OFF_XM), DM, (const u16*)(ws + OFF_WOUTO), DM, DM, (tI / NTN) * 256, (tI % NTN) * 128, smem,
                     EpiOut{p.out, (const float*)(ws + OFF_STATS), p.e_ln_g, p.e_ln_b, (const float*)(ws + OFF_MODO), 0.f, 0.f, 0.f});
    } else
    for (int tI = blockIdx.x; tI < NTILES; tI += G)
      gemm_tile<false>((const u16*)(ws + OFF_XM), DM, (const u16*)(ws + OFF_WOUTO), DM, DM, (tI / NTN) * 128, (tI % NTN) * 128, smem,
                       EpiOut{p.out, (const float*)(ws + OFF_STATS), p.e_ln_g, p.e_ln_b, (const float*)(ws + OFF_MODO), 0.f, 0.f, 0.f});
  } PH_END
  PH_BEGIN(10) phase10(p); PH_END
#ifdef EXTRA_SYNCS
  for (int i_ = 0; i_ < EXTRA_SYNCS; ++i_) xcd_barrier(xb);
#endif
#ifdef TELE_GRID
  grid.sync();
  if (blockIdx.x == 0 && tid_opaque() == 0) p.out[0] += (float)gridDim.x;
#endif
#ifdef TELE_CYC
  grid.sync();
  if (blockIdx.x == 0 && tid_opaque() == 0) p.out[0] += __hip_atomic_load(&tele_cyc_out[0], __ATOMIC_RELAXED, __HIP_MEMORY_SCOPE_AGENT);
#endif
#ifdef SELFCHECK
  grid.sync();
  if (blockIdx.x == 0 && tid_opaque() == 0) {
    const float* tl = (const float*)(ws + OFF_TELE);
    p.out[0] += 1000.f * tele_digit(tl[SELFCHECK_A]) + 100.f * tele_digit(tl[SELFCHECK_B]);
  }
#endif
}

extern "C" void kernel_launch(void* const* d_in, const int* in_sizes, int n_in, void* d_out, int out_size, void* d_ws, size_t ws_size,
                              hipStream_t stream) {
  static int grid_blocks = 0;
  if (!grid_blocks) {
    int dev = 0, cus = 0, per_cu = 0;
    hipGetDevice(&dev);
    hipDeviceGetAttribute(&cus, hipDeviceAttributeMultiprocessorCount, dev);
    hipFuncSetAttribute((const void*)fwd_megakernel, hipFuncAttributeMaxDynamicSharedMemorySize, SMEM_BYTES);
    hipOccupancyMaxActiveBlocksPerMultiprocessor(&per_cu, fwd_megakernel, 256, SMEM_BYTES);
    if (per_cu > 2) per_cu = 2;
    if (per_cu < 1) per_cu = 1;
    grid_blocks = cus * per_cu;
    if ((size_t)OFF_END > ws_size) fprintf(stderr, "workspace too small: need %u have %zu\n", OFF_END, ws_size);
  }
  Params p{};
  const float** f = (const float**)&p;
  for (int i = 0; i < 26; ++i) f[i] = (const float*)d_in[i];
  p.out = (float*)d_out;
  p.ws = (char*)d_ws;
  p.phase_lo = 0;
  p.phase_hi = 10;
  void* args[] = {&p};
  hipMemsetAsync((char*)d_ws + OFF_BAR, 0, XCD_BAR_WORDS * sizeof(unsigned), stream);
  hipError_t e = hipLaunchCooperativeKernel((void*)fwd_megakernel, dim3(grid_blocks), dim3(256), args, SMEM_BYTES, stream);
  if (e != hipSuccess) fprintf(stderr, "cooperative launch failed: %s (grid %d)\n", hipGetErrorString(e), grid_blocks);
}
```

```cpp
#include <hip/hip_runtime.h>
#include <hip/hip_cooperative_groups.h>
#include <cstdio>
namespace cg = cooperative_groups;

typedef unsigned short u16;
typedef short bf16x8 __attribute__((ext_vector_type(8)));
typedef short s16x4 __attribute__((ext_vector_type(4)));
typedef float f32x16 __attribute__((ext_vector_type(16)));
typedef __bf16 bf2_t __attribute__((ext_vector_type(2)));
typedef float f2_t __attribute__((ext_vector_type(2)));
typedef __attribute__((address_space(3))) s16x4 lds_s16x4;
typedef unsigned u32x4 __attribute__((ext_vector_type(4)));
typedef float f32x4 __attribute__((ext_vector_type(4)));
typedef unsigned u32x2 __attribute__((ext_vector_type(2)));

#define DI __device__ __forceinline__
#define MFMA(a, b, c) __builtin_amdgcn_mfma_f32_32x32x16_bf16((a), (b), (c), 0, 0, 0)

#define NLAT 32768
#define NCTX 1024
#define NTOK 33792
#define DM 1024
#define SEQ 8192
#define CTXL 256
#define TKV 8448
#define HSTR 2560
#define EVEN_IN 2464
#define C_CQ 0
#define C_CKV 384
#define C_KR 640
#define C_GA 672
#define C_QB 1184
#define C_KB 1696
#define C_VB 1824
#define C_GB 1952
#define ALPHA 1.4142135623730951f
#define LN_EPS 1e-6f
#define LOG2E 1.4426950408889634f
#define A_QSCALE (0.10206207261596577f * LOG2E)
#define B_QSCALE (0.125f * LOG2E)

#define OFF_MODE   0u
#define OFF_MODC   49152u
#define OFF_MODO   61440u
#define OFF_STATS  131072u
#define OFF_WINE   (OFF_STATS + 262144u)
#define OFF_WUQ    (OFF_WINE + 2560u*1024u*2u)
#define OFF_WUKV   (OFF_WUQ + 768u*384u*2u)
#define OFF_WOUTE  (OFF_WUKV + 1024u*256u*2u)
#define OFF_WINO   (OFF_WOUTE + 1024u*1024u*2u)
#define OFF_WOUTO  (OFF_WINO + 3072u*1024u*2u)
#define OFF_WS     (OFF_WOUTO + 1024u*1024u*2u)
#define OFF_XM     (OFF_WS + 8u*128u*128u*2u)
#define OFF_H      (OFF_XM + 33792u*1024u*2u)
#define OFF_QA     (OFF_H + 32768u*3072u*2u)
#define OFF_KA     (OFF_QA + 4u*8u*8192u*96u*2u)
#define OFF_VA     (OFF_KA + 4u*8u*8448u*96u*2u)
#define OFF_QB     (OFF_VA + 4u*8u*8448u*64u*2u)
#define OFF_KB     (OFF_QB + 4u*8u*8192u*64u*2u)
#define OFF_VB     (OFF_KB + 4u*2u*8448u*64u*2u)
#define OFF_END    (OFF_VB + 4u*2u*8448u*64u*2u)

struct Params {
  const float *x, *c, *ctx, *c_ctx, *e_w_mod, *e_b_mod, *e_w_in, *e_a_q_norm, *e_a_kv_norm, *e_a_w_uq, *e_a_w_ukv,
      *e_b_q_norm, *e_b_k_norm, *e_w_out, *e_ln_g, *e_ln_b, *o_w_mod, *o_b_mod, *o_w_in, *o_v_ln_g, *o_v_ln_b, *o_w_s,
      *o_b_s, *o_w_out, *o_ln_g, *o_ln_b;
  float* out;
  char* ws;
  int phase_lo, phase_hi;
};

DI int tid_opaque() { int t = threadIdx.x; asm volatile("" : "+v"(t)); return t; }
DI u32x4 mk4(unsigned a, unsigned b, unsigned c, unsigned d) { u32x4 r = {a, b, c, d}; return r; }
DI u32x2 mk2(unsigned a, unsigned b) { u32x2 r = {a, b}; return r; }
DI unsigned pack2(float a, float b) { f2_t v = {a, b}; bf2_t r = __builtin_convertvector(v, bf2_t); return __builtin_bit_cast(unsigned, r); }
DI u16 f2bf(float a) { return (u16)(pack2(a, 0.f) & 0xffffu); }
DI float bf2f(u16 v) { return __uint_as_float(((unsigned)v) << 16); }
DI float bflo(unsigned v) { return __uint_as_float(v << 16); }
DI float bfhi(unsigned v) { return __uint_as_float(v & 0xffff0000u); }
DI int crow(int r, int hh) { return (r & 3) + 8 * (r >> 2) + 4 * hh; }
DI float silu_f(float x) { return x * __builtin_amdgcn_rcpf(1.f + __builtin_amdgcn_exp2f(-LOG2E * x)); }
DI float gelu_f(float x) {
  const float u2 = x * (1.5957691216057308f + 0.07135481627260815f * x * x);
  return x * __builtin_amdgcn_rcpf(1.f + __builtin_amdgcn_exp2f(-LOG2E * u2));
}
DI float wave_sum(float v) {
#pragma unroll
  for (int o = 32; o > 0; o >>= 1) v += __shfl_xor(v, o);
  return v;
}

#define GSTR 144
#define GSTAGE (2 * 128 * GSTR)
template <bool ROWSS, class Epi, int ABL = 0>
DI void gemm_tile(const u16* __restrict__ A, int lda, const u16* __restrict__ Bt, int ldb, int K, int m0, int n0, char* smem, Epi epi) {
  const int t = tid_opaque(), lane = t & 63, w = t >> 6, wm = w >> 1, wn = w & 1, l31 = lane & 31, hh = lane >> 5;
  float* sRow = (float*)(smem + 2 * GSTAGE);
  f32x16 acc[2][2];
#pragma unroll
  for (int i = 0; i < 2; ++i)
#pragma unroll
    for (int j = 0; j < 2; ++j)
#pragma unroll
      for (int r = 0; r < 16; ++r) acc[i][j][r] = 0.f;
  const int lrow = t >> 3, lkc = t & 7;
  const u16* gA = A + (size_t)(m0 + lrow) * lda + lkc * 8;
  const u16* gB = Bt + (size_t)(n0 + lrow) * ldb + lkc * 8;
  u32x4 ra[4], rb[4];
  float ss[4] = {0.f, 0.f, 0.f, 0.f};
#define G_LOAD(k0_) { _Pragma("unroll") for (int i = 0; i < 4; ++i) { \
      ra[i] = *(const u32x4*)(gA + (size_t)(32 * i) * lda + (k0_)); rb[i] = *(const u32x4*)(gB + (size_t)(32 * i) * ldb + (k0_)); } }
#define G_STORE(st_) { char* dA_ = smem + (st_) * GSTAGE; char* dB_ = dA_ + 128 * GSTR; _Pragma("unroll") for (int i = 0; i < 4; ++i) { \
      *(u32x4*)(dA_ + (lrow + 32 * i) * GSTR + lkc * 16) = ra[i]; *(u32x4*)(dB_ + (lrow + 32 * i) * GSTR + lkc * 16) = rb[i]; \
      if (ROWSS) { float a0 = bflo(ra[i].x), a1 = bfhi(ra[i].x), a2 = bflo(ra[i].y), a3 = bfhi(ra[i].y); \
        float a4 = bflo(ra[i].z), a5 = bfhi(ra[i].z), a6 = bflo(ra[i].w), a7 = bfhi(ra[i].w); \
        ss[i] += a0 * a0 + a1 * a1 + a2 * a2 + a3 * a3 + a4 * a4 + a5 * a5 + a6 * a6 + a7 * a7; } } }
  const int NK = K >> 6;
  if (!ROWSS) {
    u32x4 ra2[4], rb2[4];
#define G_LOAD2(k0_) { _Pragma("unroll") for (int i = 0; i < 4; ++i) { \
      ra2[i] = *(const u32x4*)(gA + (size_t)(32 * i) * lda + (k0_)); rb2[i] = *(const u32x4*)(gB + (size_t)(32 * i) * ldb + (k0_)); } }
#define G_STORE2(st_) { char* dA_ = smem + (st_) * GSTAGE; char* dB_ = dA_ + 128 * GSTR; _Pragma("unroll") for (int i = 0; i < 4; ++i) { \
      *(u32x4*)(dA_ + (lrow + 32 * i) * GSTR + lkc * 16) = ra2[i]; *(u32x4*)(dB_ + (lrow + 32 * i) * GSTR + lkc * 16) = rb2[i]; } }
#define G_COMPUTE(st_) { const char* cA = smem + (st_) * GSTAGE; const char* cB = cA + 128 * GSTR; \
      _Pragma("unroll") for (int s = 0; s < 4; ++s) { bf16x8 af[2], bf[2]; \
        _Pragma("unroll") for (int i = 0; i < 2; ++i) af[i] = *(const bf16x8*)(cA + (wm * 64 + i * 32 + l31) * GSTR + s * 32 + hh * 16); \
        _Pragma("unroll") for (int j = 0; j < 2; ++j) bf[j] = *(const bf16x8*)(cB + (wn * 64 + j * 32 + l31) * GSTR + s * 32 + hh * 16); \
        _Pragma("unroll") for (int i = 0; i < 2; ++i) _Pragma("unroll") for (int j = 0; j < 2; ++j) acc[i][j] = MFMA(af[i], bf[j], acc[i][j]); } }
    G_LOAD(0);
    __syncthreads();
    G_STORE(0);
    if (NK > 1) G_LOAD(64);
    if (NK > 2) G_LOAD2(128);
#pragma unroll 1
    for (int kt = 0; kt < NK; kt += 2) {
      __syncthreads();
      if (kt + 1 < NK) G_STORE(1);
      if (kt + 3 < NK) G_LOAD((kt + 3) * 64);
      G_COMPUTE(0);
      if (kt + 1 < NK) {
        __syncthreads();
        if (kt + 2 < NK) G_STORE2(0);
        if (kt + 4 < NK) G_LOAD2((kt + 4) * 64);
        G_COMPUTE(1);
      }
    }
#undef G_LOAD2
#undef G_STORE2
#undef G_COMPUTE
  } else {
  G_LOAD(0);
  __syncthreads();
  G_STORE(0);
  if (NK > 1) G_LOAD(64);
#pragma unroll 1
  for (int kt = 0; kt < NK; ++kt) {
    __syncthreads();
    const char* cA = smem + (kt & 1) * GSTAGE;
    const char* cB = cA + 128 * GSTR;
if (!ROWSS) {
      bf16x8 af[4][2], bf[4][2];
#pragma unroll
      for (int s = 0; s < 4; ++s) {
#pragma unroll
        for (int i = 0; i < 2; ++i) af[s][i] = *(const bf16x8*)(cA + (wm * 64 + i * 32 + l31) * GSTR + s * 32 + hh * 16);
#pragma unroll
        for (int j = 0; j < 2; ++j) bf[s][j] = *(const bf16x8*)(cB + (wn * 64 + j * 32 + l31) * GSTR + s * 32 + hh * 16);
      }
      if (ABL != 2) {
      if (kt + 1 < NK) G_STORE((kt + 1) & 1);
      if (kt + 2 < NK) G_LOAD((kt + 2) * 64);
      }
      __builtin_amdgcn_sched_barrier(0);
      if (ABL != 1) {
#pragma unroll
      for (int s = 0; s < 4; ++s)
#pragma unroll
        for (int i = 0; i < 2; ++i)
#pragma unroll
          for (int j = 0; j < 2; ++j) acc[i][j] = MFMA(af[s][i], bf[s][j], acc[i][j]);
      } else {
#pragma unroll
      for (int s = 0; s < 4; ++s)
#pragma unroll
        for (int i = 0; i < 2; ++i) asm volatile("" :: "v"(af[s][i]), "v"(bf[s][i]));
      }
    } else {
      if (kt + 1 < NK) G_STORE((kt + 1) & 1);
      if (kt + 2 < NK) G_LOAD((kt + 2) * 64);
#pragma unroll
      for (int s = 0; s < 4; ++s) {
        bf16x8 af[2], bf[2];
#pragma unroll
        for (int i = 0; i < 2; ++i) af[i] = *(const bf16x8*)(cA + (wm * 64 + i * 32 + l31) * GSTR + s * 32 + hh * 16);
#pragma unroll
        for (int j = 0; j < 2; ++j) bf[j] = *(const bf16x8*)(cB + (wn * 64 + j * 32 + l31) * GSTR + s * 32 + hh * 16);
#pragma unroll
        for (int i = 0; i < 2; ++i)
#pragma unroll
          for (int j = 0; j < 2; ++j) acc[i][j] = MFMA(af[i], bf[j], acc[i][j]);
      }
    }
  }
  }
#undef G_LOAD
#undef G_STORE
  if (ROWSS) {
#pragma unroll
    for (int i = 0; i < 4; ++i) {
      float v = ss[i];
      v += __shfl_xor(v, 1);
      v += __shfl_xor(v, 2);
      v += __shfl_xor(v, 4);
      if (lkc == 0) sRow[lrow + 32 * i] = rsqrtf(v / (float)K + LN_EPS);
    }
    __syncthreads();
  }
  {
    float* sC = (float*)smem;
    __syncthreads();
#pragma unroll
    for (int i = 0; i < 2; ++i)
#pragma unroll
      for (int j = 0; j < 2; ++j)
#pragma unroll
        for (int r = 0; r < 16; ++r)
          sC[(wm * 64 + i * 32 + crow(r, hh)) * 132 + wn * 64 + j * 32 + l31] = acc[i][j][r];
    __syncthreads();
    epi.prep(m0, n0 + (t & 15) * 8);
#pragma unroll 1
    for (int it = 0; it < 8; ++it) {
      const int idx = t + 256 * it, pr = idx >> 4, cc = idx & 15;
      const f32x4 v0 = *(const f32x4*)(sC + pr * 132 + cc * 8), v1 = *(const f32x4*)(sC + pr * 132 + cc * 8 + 4);
      if (ROWSS) epi.row8s(m0 + pr, n0 + cc * 8, v0, v1, sC + pr * 132 + (cc ^ 1) * 8, sRow[pr]);
      else epi.row8(m0 + pr, n0 + cc * 8, v0, v1);
    }
  }
}

#define G2_BOFF (256 * GSTR)
template <class Epi>
DI void gemm_tile256(const u16* __restrict__ A, int lda, const u16* __restrict__ Bt, int ldb, int K, int m0, int n0, char* smem, Epi epi) {
  const int t = tid_opaque(), lane = t & 63, w = t >> 6, l31 = lane & 31, hh = lane >> 5;
  f32x16 acc[2][4];
#pragma unroll
  for (int i = 0; i < 2; ++i)
#pragma unroll
    for (int j = 0; j < 4; ++j)
#pragma unroll
      for (int r = 0; r < 16; ++r) acc[i][j][r] = 0.f;
  const int lrow = t >> 3, lkc = t & 7;
  const u16* gA = A + (size_t)(m0 + lrow) * lda + lkc * 8;
  const u16* gB = Bt + (size_t)(n0 + lrow) * ldb + lkc * 8;
  u32x4 ra[8], rb[4];
#pragma unroll
  for (int i = 0; i < 8; ++i) ra[i] = *(const u32x4*)(gA + (size_t)(32 * i) * lda);
#pragma unroll
  for (int i = 0; i < 4; ++i) rb[i] = *(const u32x4*)(gB + (size_t)(32 * i) * ldb);
  char* sA = smem;
  char* sB = smem + G2_BOFF;
#pragma unroll 1
  for (int k0 = 0; k0 < K; k0 += 64) {
    __syncthreads();
#pragma unroll
    for (int i = 0; i < 8; ++i) *(u32x4*)(sA + (lrow + 32 * i) * GSTR + lkc * 16) = ra[i];
#pragma unroll
    for (int i = 0; i < 4; ++i) *(u32x4*)(sB + (lrow + 32 * i) * GSTR + lkc * 16) = rb[i];
    __syncthreads();
    if (k0 + 64 < K) {
#pragma unroll
      for (int i = 0; i < 8; ++i) ra[i] = *(const u32x4*)(gA + (size_t)(32 * i) * lda + k0 + 64);
#pragma unroll
      for (int i = 0; i < 4; ++i) rb[i] = *(const u32x4*)(gB + (size_t)(32 * i) * ldb + k0 + 64);
    }
#pragma unroll
    for (int s = 0; s < 4; ++s) {
      bf16x8 af[2], bf[4];
#pragma unroll
      for (int i = 0; i < 2; ++i) af[i] = *(const bf16x8*)(sA + (w * 64 + i * 32 + l31) * GSTR + s * 32 + hh * 16);
#pragma unroll
      for (int j = 0; j < 4; ++j) bf[j] = *(const bf16x8*)(sB + (j * 32 + l31) * GSTR + s * 32 + hh * 16);
#pragma unroll
      for (int i = 0; i < 2; ++i)
#pragma unroll
        for (int j = 0; j < 4; ++j) acc[i][j] = MFMA(af[i], bf[j], acc[i][j]);
    }
  }
  float* sC = (float*)smem;
  epi.prep(m0, n0 + (t & 15) * 8);
#pragma unroll
  for (int half = 0; half < 2; ++half) {
    __syncthreads();
    if ((w >> 1) == half) {
#pragma unroll
      for (int i = 0; i < 2; ++i)
#pragma unroll
        for (int j = 0; j < 4; ++j)
#pragma unroll
          for (int r = 0; r < 16; ++r)
            sC[((w & 1) * 64 + i * 32 + crow(r, hh)) * 132 + j * 32 + l31] = acc[i][j][r];
    }
    __syncthreads();
#pragma unroll 1
    for (int it = 0; it < 8; ++it) {
      const int idx = t + 256 * it, pr = idx >> 4, cc = idx & 15;
      const f32x4 v0 = *(const f32x4*)(sC + pr * 132 + cc * 8), v1 = *(const f32x4*)(sC + pr * 132 + cc * 8 + 4);
      epi.row8(m0 + half * 128 + pr, n0 + cc * 8, v0, v1);
    }
  }
}

#define OPAQUE(ptr) asm volatile("" : "+v"(ptr))
struct EpiH {
  u16* H;
  DI void begin(int rbase, int col) { H += (size_t)rbase * HSTR + col; OPAQUE(H); }
  DI void elem(int ro, float v) const { H[ro * HSTR] = f2bf(v); }
  DI void row8(int row, int col, f32x4 a, f32x4 b) const {
    *(u32x4*)(H + (size_t)row * HSTR + col) = mk4(pack2(a.x, a.y), pack2(a.z, a.w), pack2(b.x, b.y), pack2(b.z, b.w));
  }
  DI void row8s(int, int, f32x4, f32x4, const float*, float) const {}
  DI void prep(int, int) {}
};
struct EpiQA {
  u16* QA;
  int s0, axis, lo8; bool isrope; float ifr;
  DI void begin(int rbase, int col) {
    const int b = rbase >> 13;
    s0 = rbase & 8191;
    const int head = col / 96, d = col - head * 96;
    QA += ((size_t)(b * 8 + head) * SEQ + s0) * 96 + d;
    OPAQUE(QA);
    isrope = ((col >> 5) % 3) == 2;
    const int i = col & 31, ii = i & 15;
    axis = i >> 4; lo8 = (ii < 8);
    ifr = exp2f(-13.287712379549449f * (float)(ii & 7) * 0.125f);
  }
  DI void elem(int ro, float v) const {
    v *= A_QSCALE;
    if (isrope) {
      const int s = s0 + ro;
      const float pos = (float)(axis ? (s & 63) : (s >> 6));
      const float ang = pos * ifr;
      const float cs = __cosf(ang), sn = __sinf(ang);
      const float pv = __shfl_xor(v, 8);
      v = lo8 ? (v * cs - pv * sn) : (v * cs + pv * sn);
    }
    QA[ro * 96] = f2bf(v);
  }
  DI void row8(int, int, f32x4, f32x4) const {}
  DI void prep(int, int) {}
  DI void row8s(int row, int col, f32x4 a, f32x4 b, const float* partner, float rs) const {
    const int bb = row >> 13, s = row & 8191;
    const int head = col / 96, d0 = col - head * 96;
    float v[8] = {a.x, a.y, a.z, a.w, b.x, b.y, b.z, b.w};
    const float sc = rs * A_QSCALE;
    if (d0 >= 64) {
      const f32x4 p0 = *(const f32x4*)partner, p1 = *(const f32x4*)(partner + 4);
      const float pv[8] = {p0.x, p0.y, p0.z, p0.w, p1.x, p1.y, p1.z, p1.w};
      const int i0 = d0 - 64;
      const float pos = (float)((i0 >> 4) ? (s & 63) : (s >> 6));
      const bool lo8 = (i0 & 8) == 0;
#pragma unroll
      for (int e = 0; e < 8; ++e) {
        const float ang = pos * exp2f(-13.287712379549449f * (float)e * 0.125f);
        const float cs = __cosf(ang), sn = __sinf(ang);
        v[e] = lo8 ? (v[e] * cs - pv[e] * sn) : (v[e] * cs + pv[e] * sn);
      }
    }
    *(u32x4*)(QA + ((size_t)(bb * 8 + head) * SEQ + s) * 96 + d0) =
        mk4(pack2(v[0] * sc, v[1] * sc), pack2(v[2] * sc, v[3] * sc), pack2(v[4] * sc, v[5] * sc), pack2(v[6] * sc, v[7] * sc));
  }
};
struct EpiKVA {
  u16 *KA, *VA;
  bool isk;
  DI void begin(int rbase, int col) {
    int b, tk;
    if (rbase < NLAT) { b = rbase >> 13; tk = CTXL + (rbase & 8191); } else { const int r2 = rbase - NLAT; b = r2 >> 8; tk = r2 & 255; }
    const int head = col >> 7, d = col & 127;
    const size_t base = (size_t)(b * 8 + head) * TKV + tk;
    isk = d < 64;
    KA += base * 96 + (d & 63);
    VA += base * 64 + (d & 63);
    OPAQUE(KA); OPAQUE(VA);
  }
  DI void elem(int ro, float v) const {
    if (isk) KA[ro * 96] = f2bf(v); else VA[ro * 64] = f2bf(v);
  }
  DI void row8(int, int, f32x4, f32x4) const {}
  DI void prep(int, int) {}
  DI void row8s(int row, int col, f32x4 a, f32x4 b, const float*, float rs) const {
    int bb, tk;
    if (row < NLAT) { bb = row >> 13; tk = CTXL + (row & 8191); } else { const int r2 = row - NLAT; bb = r2 >> 8; tk = r2 & 255; }
    const int head = col >> 7, d0 = col & 127;
    const size_t base = (size_t)(bb * 8 + head) * TKV + tk;
    u16* dst = (d0 < 64) ? KA + base * 96 + d0 : VA + base * 64 + (d0 - 64);
    *(u32x4*)dst = mk4(pack2(a.x * rs, a.y * rs), pack2(a.z * rs, a.w * rs), pack2(b.x * rs, b.y * rs), pack2(b.z * rs, b.w * rs));
  }
};
struct EpiZ {
  const float* x; const float* modE; float* Z;
  float gate;
  DI void begin(int rbase, int col) {
    gate = modE[(rbase >> 13) * 3072 + 2048 + col];
    x += (size_t)rbase * DM + col; Z += (size_t)rbase * DM + col;
    OPAQUE(x); OPAQUE(Z);
  }
  DI void elem(int ro, float v) const { Z[ro * DM] = ALPHA * x[ro * DM] + gate * v; }
  f32x4 pg0, pg1;
  DI void prep(int row0, int col) {
    const float* gp = modE + (row0 >> 13) * 3072 + 2048 + col;
    pg0 = *(const f32x4*)gp; pg1 = *(const f32x4*)(gp + 4);
  }
  DI void row8(int row, int col, f32x4 a, f32x4 b) const {
    const size_t idx = (size_t)row * DM + col;
    const f32x4 x0 = *(const f32x4*)(x + idx), x1 = *(const f32x4*)(x + idx + 4);
    *(f32x4*)(Z + idx) = ALPHA * x0 + pg0 * a;
    *(f32x4*)(Z + idx + 4) = ALPHA * x1 + pg1 * b;
  }
  DI void row8s(int, int, f32x4, f32x4, const float*, float) const {}
};
struct EpiNull {
  u16* H2;
  DI void begin(int rbase, int col) { H2 += (size_t)rbase * 3072 + col; OPAQUE(H2); }
  DI void elem(int ro, float v) const { if (v == 12345.678f) H2[ro * 3072] = 0; }
  DI void row8(int row, int col, f32x4 a, f32x4 b) const { if (a.x == 12345.678f) H2[(size_t)row * 3072 + col] = 0; }
  DI void row8s(int, int, f32x4, f32x4, const float*, float) const {}
  DI void prep(int, int) {}
};
struct EpiH2 {
  u16* H2;
  bool isg;
  DI void begin(int rbase, int col) { isg = col < 2048; H2 += (size_t)rbase * 3072 + col; OPAQUE(H2); }
  DI void elem(int ro, float v) const { H2[ro * 3072] = f2bf(isg ? gelu_f(v) : silu_f(v)); }
  DI void row8(int row, int col, f32x4 a, f32x4 b) const {
    float r[8] = {a.x, a.y, a.z, a.w, b.x, b.y, b.z, b.w};
    if (col < 2048) {
#pragma unroll
      for (int e = 0; e < 8; ++e) r[e] = gelu_f(r[e]);
    } else {
#pragma unroll
      for (int e = 0; e < 8; ++e) r[e] = silu_f(r[e]);
    }
    *(u32x4*)(H2 + (size_t)row * 3072 + col) = mk4(pack2(r[0], r[1]), pack2(r[2], r[3]), pack2(r[4], r[5]), pack2(r[6], r[7]));
  }
  DI void row8s(int, int, f32x4, f32x4, const float*, float) const {}
  DI void prep(int, int) {}
};
struct EpiOut {
  float* Z; const float* stats; const float* lng; const float* lnb; const float* modO;
  float g, bb, gate;
  DI void begin(int rbase, int col) {
    g = lng[col]; bb = lnb[col]; gate = modO[(rbase >> 13) * 3072 + 2048 + col];
    Z += (size_t)rbase * DM + col; stats += (size_t)rbase * 2;
    OPAQUE(Z); OPAQUE(stats);
  }
  DI void elem(int ro, float v) const {
    const float mu = stats[ro * 2], rstd = stats[ro * 2 + 1];
    const float x1 = (Z[ro * DM] - mu) * rstd * g + bb;
    Z[ro * DM] = ALPHA * x1 + gate * v;
  }
  f32x4 pl0, pl1, pc0, pc1, pg0, pg1;
  DI void prep(int row0, int col) {
    const float* gp = modO + (row0 >> 13) * 3072 + 2048 + col;
    pl0 = *(const f32x4*)(lng + col); pl1 = *(const f32x4*)(lng + col + 4);
    pc0 = *(const f32x4*)(lnb + col); pc1 = *(const f32x4*)(lnb + col + 4);
    pg0 = *(const f32x4*)gp; pg1 = *(const f32x4*)(gp + 4);
  }
  DI void row8(int row, int col, f32x4 a, f32x4 b) const {
    const size_t idx = (size_t)row * DM + col;
    const float mu = stats[row * 2], rstd = stats[row * 2 + 1];
    const f32x4 z0 = *(const f32x4*)(Z + idx), z1 = *(const f32x4*)(Z + idx + 4);
    *(f32x4*)(Z + idx) = ALPHA * ((z0 - mu) * rstd * pl0 + pc0) + pg0 * a;
    *(f32x4*)(Z + idx + 4) = ALPHA * ((z1 - mu) * rstd * pl1 + pc1) + pg1 * b;
  }
  DI void row8s(int, int, f32x4, f32x4, const float*, float) const {}
};

DI void transpose_tile(const float* __restrict__ src, int K, int N, u16* __restrict__ dst, int tile_n, int tile_k, const float* gk, char* smem) {
  float* tl = (float*)smem;
  const int t = tid_opaque();
  __syncthreads();
#pragma unroll
  for (int i = 0; i < 16; ++i) {
    const int kk = i * 4 + (t >> 6), nn = t & 63;
    const int k = tile_k * 64 + kk, n = tile_n * 64 + nn;
    float v = (n < N) ? src[(size_t)k * N + n] : 0.f;
    if (gk) v *= gk[k];
    tl[kk * 65 + nn] = v;
  }
  __syncthreads();
  const int nn = t >> 2, ks = (t & 3) * 16;
  unsigned pk[8];
#pragma unroll
  for (int e = 0; e < 8; ++e) pk[e] = pack2(tl[(ks + 2 * e) * 65 + nn], tl[(ks + 2 * e + 1) * 65 + nn]);
  u16* d = dst + (size_t)(tile_n * 64 + nn) * K + tile_k * 64 + ks;
  *(u32x4*)d = mk4(pk[0], pk[1], pk[2], pk[3]);
  *(u32x4*)(d + 8) = mk4(pk[4], pk[5], pk[6], pk[7]);
}

DI void gemv_item(const Params& p, int item, char* smem) {
  const int layer = item / 96, col0 = (item % 96) * 32;
  const float* wmod = layer ? p.o_w_mod : p.e_w_mod;
  const float* bmod = layer ? p.o_b_mod : p.e_b_mod;
  float* sc = (float*)smem;
  float* red = sc + 5 * 1024;
  const int t = tid_opaque();
  __syncthreads();
  for (int i = t; i < 5 * 1024; i += 256) {
    const float cv = (i < 4096) ? p.c[i] : p.c_ctx[i - 4096];
    sc[i] = silu_f(cv);
  }
  __syncthreads();
  const int col = t & 31, kg = t >> 5;
  float a0 = 0.f, a1 = 0.f, a2 = 0.f, a3 = 0.f, a4 = 0.f;
  const float* wp = wmod + (size_t)(kg * 128) * 3072 + col0 + col;
#pragma unroll 8
  for (int k = 0; k < 128; ++k) {
    const float wv = wp[(size_t)k * 3072];
    const int kk = kg * 128 + k;
    a0 += sc[kk] * wv; a1 += sc[1024 + kk] * wv; a2 += sc[2048 + kk] * wv; a3 += sc[3072 + kk] * wv; a4 += sc[4096 + kk] * wv;
  }
  red[(kg * 5 + 0) * 32 + col] = a0; red[(kg * 5 + 1) * 32 + col] = a1; red[(kg * 5 + 2) * 32 + col] = a2;
  red[(kg * 5 + 3) * 32 + col] = a3; red[(kg * 5 + 4) * 32 + col] = a4;
  __syncthreads();
  if (t < 160) {
    const int v = t >> 5, cc = t & 31;
    float s = 0.f;
#pragma unroll
    for (int g = 0; g < 8; ++g) s += red[(g * 5 + v) * 32 + cc];
    s += bmod[col0 + cc];
    float* modE = (float*)(p.ws + OFF_MODE);
    float* modC = (float*)(p.ws + OFF_MODC);
    float* modO = (float*)(p.ws + OFF_MODO);
    if (layer == 0) { if (v < 4) modE[v * 3072 + col0 + cc] = s; else modC[col0 + cc] = s; }
    else { if (v < 4) modO[v * 3072 + col0 + cc] = s; }
  }
}

DI void phase0(const Params& p, char* smem) {
  const int NI = 192 + 640 + 72 + 64 + 256 + 768 + 256 + 32;
  for (int it = blockIdx.x; it < NI; it += gridDim.x) {
    int i = it;
    if (i < 192) { gemv_item(p, i, smem); continue; }
    i -= 192;
    if (i < 640) { transpose_tile(p.e_w_in, 1024, EVEN_IN, (u16*)(p.ws + OFF_WINE), i / 16, i % 16, nullptr, smem); continue; }
    i -= 640;
    if (i < 72) { transpose_tile(p.e_a_w_uq, 384, 768, (u16*)(p.ws + OFF_WUQ), i / 6, i % 6, p.e_a_q_norm, smem); continue; }
    i -= 72;
    if (i < 64) { transpose_tile(p.e_a_w_ukv, 256, 1024, (u16*)(p.ws + OFF_WUKV), i / 4, i % 4, p.e_a_kv_norm, smem); continue; }
    i -= 64;
    if (i < 256) { transpose_tile(p.e_w_out, 1024, 1024, (u16*)(p.ws + OFF_WOUTE), i / 16, i % 16, nullptr, smem); continue; }
    i -= 256;
    if (i < 768) { transpose_tile(p.o_w_in, 1024, 3072, (u16*)(p.ws + OFF_WINO), i / 16, i % 16, nullptr, smem); continue; }
    i -= 768;
    if (i < 256) { transpose_tile(p.o_w_out, 1024, 1024, (u16*)(p.ws + OFF_WOUTO), i / 16, i % 16, nullptr, smem); continue; }
    i -= 256;
    {
      u16* dst = (u16*)(p.ws + OFF_WS);
      const int base = i * 4096 + tid_opaque() * 16;
#pragma unroll
      for (int e = 0; e < 16; e += 2) *(unsigned*)(dst + base + e) = pack2(p.o_w_s[base + e], p.o_w_s[base + e + 1]);
    }
  }
}

DI void phase1(const Params& p) {
  const float* modE = (const float*)(p.ws + OFF_MODE);
  const float* modC = (const float*)(p.ws + OFF_MODC);
  u16* XM = (u16*)(p.ws + OFF_XM);
  const size_t total = (size_t)NTOK * 128;
  for (size_t g = (size_t)blockIdx.x * 256 + tid_opaque(); g < total; g += (size_t)gridDim.x * 256) {
    const int row = (int)(g >> 7), k = (int)(g & 127) * 8;
    const float* src; const float* md;
    if (row < NLAT) { src = p.x + (size_t)row * DM; md = modE + (row >> 13) * 3072; }
    else { src = p.ctx + (size_t)(row - NLAT) * DM; md = modC; }
    const f32x4 x0 = *(const f32x4*)(src + k), x1 = *(const f32x4*)(src + k + 4);
    const f32x4 sh0 = *(const f32x4*)(md + k), sh1 = *(const f32x4*)(md + k + 4);
    const f32x4 s0 = *(const f32x4*)(md + 1024 + k), s1 = *(const f32x4*)(md + 1024 + k + 4);
    u32x4 o;
    o.x = pack2(x0.x * (1.f + s0.x) + sh0.x, x0.y * (1.f + s0.y) + sh0.y);
    o.y = pack2(x0.z * (1.f + s0.z) + sh0.z, x0.w * (1.f + s0.w) + sh0.w);
    o.z = pack2(x1.x * (1.f + s1.x) + sh1.x, x1.y * (1.f + s1.y) + sh1.y);
    o.w = pack2(x1.z * (1.f + s1.z) + sh1.z, x1.w * (1.f + s1.w) + sh1.w);
    *(u32x4*)(XM + (size_t)row * DM + k) = o;
  }
}

DI void unpack8(u32x4 r, float (&x)[8]) {
  x[0] = bflo(r.x); x[1] = bfhi(r.x); x[2] = bflo(r.y); x[3] = bfhi(r.y); x[4] = bflo(r.z); x[5] = bfhi(r.z); x[6] = bflo(r.w); x[7] = bfhi(r.w);
}
DI u32x4 pack8(const float (&x)[8]) { return mk4(pack2(x[0], x[1]), pack2(x[2], x[3]), pack2(x[4], x[5]), pack2(x[6], x[7])); }
DI void phase3_elem(const Params& p) {
  const u16* H = (const u16*)(p.ws + OFF_H);
  u16* KA = (u16*)(p.ws + OFF_KA);
  u16* QB = (u16*)(p.ws + OFF_QB);
  u16* KB = (u16*)(p.ws + OFF_KB);
  u16* VB = (u16*)(p.ws + OFF_VB);
  const int t = tid_opaque(), lane = t & 63;
  const int gw = blockIdx.x * 4 + (t >> 6), nw = gridDim.x * 4;
  const int hdA = lane >> 3, d0 = (lane & 7) * 8;
  const bool axB = ((lane & 7) >> 2) != 0, loB = (lane & 2) == 0;
  const int fi0 = (lane & 1) * 8;
  float ifB[8], ifA[8], gq[8], gk[8];
#pragma unroll
  for (int e = 0; e < 8; ++e) {
    ifB[e] = exp2f(-13.287712379549449f * (float)(fi0 + e) * 0.0625f);
    ifA[e] = exp2f(-13.287712379549449f * (float)e * 0.125f);
    gq[e] = p.e_b_q_norm[d0 + e];
    gk[e] = p.e_b_k_norm[d0 + e];
  }
  const int l16 = lane & 15, hd2 = l16 >> 3, l4 = lane & 3;
  const bool isk = lane < 16;
  for (int row = gw; row < NTOK; row += nw) {
    int b, tk, sq; bool lat;
    if (row < NLAT) { b = row >> 13; sq = row & 8191; tk = CTXL + sq; lat = true; }
    else { const int r2 = row - NLAT; b = r2 >> 8; tk = r2 & 255; sq = 0; lat = false; }
    const u16* hr = H + (size_t)row * HSTR;
    const float posr = (float)(sq >> 6), posc = (float)(sq & 63);
    const float posB = axB ? posc : posr;
    const u32x4 rawq = *(const u32x4*)(hr + C_QB + lane * 8);
    const u32x4 rawk = *(const u32x4*)(hr + (isk ? C_KB : C_VB) + l16 * 8);
    const u32x4 rawr = *(const u32x4*)(hr + C_KR + l4 * 8);
    float csB[8], snB[8];
    if (lat) {
#pragma unroll
      for (int e = 0; e < 8; ++e) { const float ang = posB * ifB[e]; csB[e] = __cosf(ang); snB[e] = __sinf(ang); }
    }
    if (lat) {
      float x[8];
      unpack8(rawq, x);
      float ss = 0.f;
#pragma unroll
      for (int e = 0; e < 8; ++e) ss += x[e] * x[e];
      ss += __shfl_xor(ss, 1); ss += __shfl_xor(ss, 2); ss += __shfl_xor(ss, 4);
      const float rs = rsqrtf(ss * (1.f / 64.f) + LN_EPS);
#pragma unroll
      for (int e = 0; e < 8; ++e) x[e] = x[e] * rs * gq[e];
      float y[8];
#pragma unroll
      for (int e = 0; e < 8; ++e) {
        const float pv = __shfl_xor(x[e], 2);
        y[e] = (loB ? (x[e] * csB[e] - pv * snB[e]) : (x[e] * csB[e] + pv * snB[e])) * B_QSCALE;
      }
      *(u32x4*)(QB + ((size_t)(b * 8 + hdA) * SEQ + sq) * 64 + d0) = pack8(y);
    }
    {
      float x[8];
      unpack8(rawk, x);
      float ss = 0.f;
#pragma unroll
      for (int e = 0; e < 8; ++e) ss += x[e] * x[e];
      ss += __shfl_xor(ss, 1); ss += __shfl_xor(ss, 2); ss += __shfl_xor(ss, 4);
      const float rs = rsqrtf(ss * (1.f / 64.f) + LN_EPS);
#pragma unroll
      for (int e = 0; e < 8; ++e) x[e] = x[e] * rs * gk[e];
      if (lat) {
        float y[8];
#pragma unroll
        for (int e = 0; e < 8; ++e) {
          const float pv = __shfl_xor(x[e], 2);
          y[e] = loB ? (x[e] * csB[e] - pv * snB[e]) : (x[e] * csB[e] + pv * snB[e]);
        }
#pragma unroll
        for (int e = 0; e < 8; ++e) x[e] = y[e];
      }
      const u32x4 outv = isk ? pack8(x) : rawk;
      if (lane < 32) *(u32x4*)((isk ? KB : VB) + ((size_t)(b * 2 + hd2) * TKV + tk) * 64 + (l16 & 7) * 8) = outv;
    }
    {
      float x[8];
      unpack8(rawr, x);
      if (lat) {
        const float posA = (l4 >> 1) ? posc : posr;
        float y[8];
#pragma unroll
        for (int e = 0; e < 8; ++e) {
          const float ang = posA * ifA[e];
          const float cs = __cosf(ang), sn = __sinf(ang);
          const float pv = __shfl_xor(x[e], 1);
          y[e] = ((l4 & 1) == 0) ? (x[e] * cs - pv * sn) : (x[e] * cs + pv * sn);
        }
#pragma unroll
        for (int e = 0; e < 8; ++e) x[e] = y[e];
      }
      if (lane < 4) {
        const u32x4 outv = pack8(x);
#pragma unroll
        for (int h = 0; h < 8; ++h) *(u32x4*)(KA + ((size_t)(b * 8 + h) * TKV + tk) * 96 + 64 + l4 * 8) = outv;
      }
    }
  }
}

#ifdef TELE_CYC
__device__ float tele_cyc_out[4];
#endif
#define VSTR 192
#define ATT_THR 6.0f
typedef unsigned u32x2v __attribute__((ext_vector_type(2)));
DI float fmax2(float a, float b) { return __builtin_amdgcn_fmed3f(a, b, __builtin_inff()); }
DI f32x16 zero16() { f32x16 z; _Pragma("unroll") for (int r = 0; r < 16; ++r) z[r] = 0.f; return z; }
DI float half_max(float x) {
  const u32x2v r = __builtin_amdgcn_permlane32_swap(__float_as_uint(x), __float_as_uint(x), false, false);
  return fmaxf(__uint_as_float(r[0]), __uint_as_float(r[1]));
}
template <int DK>
struct AttnCtx {
  static constexpr int KSTR = DK * 2 + 16;
  static constexpr int CK = DK / 8;
  static constexpr int NKC = 64 * CK / 256;
  static constexpr int NKS = DK / 16;
  static constexpr int KBYTES = 64 * KSTR;
  static constexpr int VBYTES = 64 * VSTR;
  static constexpr int NT = TKV / 64;
};

#define SGB_MFMA 0x008
#define SGB_VALU 0x002
#define SGB_DSRD 0x100
#define FENCE() __builtin_amdgcn_sched_barrier(0)
DI void sm_quad(int r, const f32x16& c0, const f32x16& c1, f2_t& ps, unsigned (&pk)[16]) {
  f2_t e, f;
  e.x = __builtin_amdgcn_exp2f(c0[r]); e.y = __builtin_amdgcn_exp2f(c0[r + 1]);
  f.x = __builtin_amdgcn_exp2f(c1[r]); f.y = __builtin_amdgcn_exp2f(c1[r + 1]);
  ps += e;
  ps += f;
  pk[r >> 1] = pack2(e.x, e.y);
  pk[8 + (r >> 1)] = pack2(f.x, f.y);
  asm volatile("" : "+v"(pk[r >> 1]), "+v"(pk[8 + (r >> 1)]), "+v"(ps));
}
template <int DK, bool DOQK>
DI void attn_half1(const char* sKn, const bf16x8 (&qf)[DK / 16], const f32x16& c0, const f32x16& c1, f32x16& n0, f32x16& n1,
                   unsigned (&pk)[16], const f32x16& negm, float& lsum, int l31, int hh) {
  constexpr int KSTR = AttnCtx<DK>::KSTR;
  constexpr int NKS = DK / 16;
  f2_t ps = {0.f, 0.f};
  if (DOQK) {
    const char* kp0 = sKn + l31 * KSTR + hh * 16;
    const char* kp1 = kp0 + 32 * KSTR;
#pragma unroll
    for (int ks = 0; ks < NKS; ++ks) {
      const bf16x8 ka = *(const bf16x8*)(kp0 + ks * 32), kb = *(const bf16x8*)(kp1 + ks * 32);
      n0 = MFMA(ka, qf[ks], ks == 0 ? negm : n0);
#pragma unroll
      for (int q = (2 * ks) * 4 / NKS; q < (2 * ks + 1) * 4 / NKS; ++q) sm_quad(2 * q, c0, c1, ps, pk);
      FENCE();
      n1 = MFMA(kb, qf[ks], ks == 0 ? negm : n1);
#pragma unroll
      for (int q = (2 * ks + 1) * 4 / NKS; q < (2 * ks + 2) * 4 / NKS; ++q) sm_quad(2 * q, c0, c1, ps, pk);
      FENCE();
    }
  } else {
#pragma unroll
    for (int q = 0; q < 8; ++q) sm_quad(2 * q, c0, c1, ps, pk);
  }
  lsum += ps.x + ps.y;
  FENCE();
}
template <int DK, bool DOQK, bool FIXED>
DI void attn_half2(const char* sVc, const unsigned (&pk)[16], f32x16& n0, f32x16& n1,
                   f32x16 (&o)[2], f32x16& negm, float& mref, float& lsum, int l31, int hh, int i16, int g16) {
  const char* vb = sVc + (hh * 4 + (i16 >> 2)) * VSTR + (g16 * 16) * 2 + (i16 & 3) * 8;
  constexpr bool DOMAX = DOQK && !FIXED;
  float mx = DOMAX ? fmaxf(n0[0], n1[0]) : 0.f;
#pragma unroll
  for (int st = 0; st < 4; ++st) {
    const char* vn = vb + st * 16 * VSTR;
    const s16x4 lo0 = __builtin_amdgcn_ds_read_tr16_b64_v4i16((lds_s16x4*)(vn));
    const s16x4 hi0 = __builtin_amdgcn_ds_read_tr16_b64_v4i16((lds_s16x4*)(vn + 8 * VSTR));
    const s16x4 lo1 = __builtin_amdgcn_ds_read_tr16_b64_v4i16((lds_s16x4*)(vn + 64));
    const s16x4 hi1 = __builtin_amdgcn_ds_read_tr16_b64_v4i16((lds_s16x4*)(vn + 64 + 8 * VSTR));
    const bf16x8 pf = __builtin_bit_cast(bf16x8, mk4(pk[st * 4], pk[st * 4 + 1], pk[st * 4 + 2], pk[st * 4 + 3]));
    o[0] = MFMA(__builtin_shufflevector(lo0, hi0, 0, 1, 2, 3, 4, 5, 6, 7), pf, o[0]);
    if (DOMAX) {
#pragma unroll
      for (int r = 4 * st; r < 4 * st + 2; ++r) if (r > 0) asm volatile("v_max3_f32 %0, %0, %1, %2" : "+v"(mx) : "v"(n0[r]), "v"(n1[r]));
    }
    FENCE();
    o[1] = MFMA(__builtin_shufflevector(lo1, hi1, 0, 1, 2, 3, 4, 5, 6, 7), pf, o[1]);
    if (DOMAX) {
#pragma unroll
      for (int r = 4 * st + 2; r < 4 * st + 4; ++r) asm volatile("v_max3_f32 %0, %0, %1, %2" : "+v"(mx) : "v"(n0[r]), "v"(n1[r]));
    }
    FENCE();
  }
  if (DOMAX) {
    mx = half_max(mx);
    if (__any(mx > ATT_THR)) {
      const float d = fmaxf(mx, 0.f);
      const float alpha = __builtin_amdgcn_exp2f(-d);
      lsum *= alpha;
      mref += d;
      {
        float guard = o[0][0] + o[1][0] + n0[0] + n1[0] + negm[0];
        asm volatile("" :: "v"(guard));
      }
#pragma unroll
      for (int r = 0; r < 16; ++r) {
        asm volatile("v_mul_f32 %0, %0, %1" : "+v"(o[0][r]) : "v"(alpha));
        asm volatile("v_mul_f32 %0, %0, %1" : "+v"(o[1][r]) : "v"(alpha));
        asm volatile("v_sub_f32 %0, %0, %1" : "+v"(n0[r]) : "v"(d));
        asm volatile("v_sub_f32 %0, %0, %1" : "+v"(n1[r]) : "v"(d));
        asm volatile("v_sub_f32 %0, %0, %1" : "+v"(negm[r]) : "v"(d));
      }
    }
  }
}

template <int DK, int ABL = 0, bool FIXED = false>
DI void attn_item(const u16* __restrict__ Qg, const u16* __restrict__ Kg, const u16* __restrict__ Vg,
                  const u16* __restrict__ gate, u16* __restrict__ outp, int qblk, char* smem, float bound = 0.f) {
  typedef AttnCtx<DK> C;
  constexpr int KSTR = C::KSTR, CK = C::CK, NKC = C::NKC, NKS = C::NKS, NT = C::NT;
  const int t = tid_opaque(), lane = t & 63, w = t >> 6, l31 = lane & 31, hh = lane >> 5;
  const int i16 = lane & 15, g16 = (lane >> 4) & 1;
  const int q0 = qblk * 128 + w * 32;
  char* sK0 = smem;
  char* sK1 = smem + C::KBYTES;
  char* sV0 = smem + 2 * C::KBYTES;
  char* sV1 = sV0 + C::VBYTES;
  bf16x8 qf[NKS];
#pragma unroll
  for (int ks = 0; ks < NKS; ++ks) qf[ks] = *(const bf16x8*)(Qg + (size_t)(q0 + l31) * DK + ks * 16 + hh * 8);
  f32x16 o[2], negm;
#pragma unroll
  for (int r = 0; r < 16; ++r) { o[0][r] = 0.f; o[1][r] = 0.f; negm[r] = FIXED ? -bound : 0.f; }
  float mref = FIXED ? bound : 0.f, lsum = 0.f;
  u32x4 rk[NKC], rv[2];
  int koff[NKC], ksoff[NKC];
#pragma unroll
  for (int i = 0; i < NKC; ++i) { const int c = t + 256 * i; const int kr = c / CK, kc = c - kr * CK; koff[i] = kr * DK + kc * 8; ksoff[i] = kr * KSTR + kc * 16; }
  const int voff = (t >> 3) * 64 + (t & 7) * 8, vsoff = (t >> 3) * VSTR + (t & 7) * 16;
#define LOADK(tile) { const u16* kp_ = Kg + (size_t)(tile) * 64 * DK; _Pragma("unroll") for (int i = 0; i < NKC; ++i) rk[i] = *(const u32x4*)(kp_ + koff[i]); }
#define LOADV(tile) { const u16* vp_ = Vg + (size_t)(tile) * 64 * 64; rv[0] = *(const u32x4*)(vp_ + voff); rv[1] = *(const u32x4*)(vp_ + voff + 32 * 64); }
#define STOREK(dst) { _Pragma("unroll") for (int i = 0; i < NKC; ++i) *(u32x4*)((dst) + ksoff[i]) = rk[i]; }
#define STOREV(dst) { *(u32x4*)((dst) + vsoff) = rv[0]; *(u32x4*)((dst) + vsoff + 32 * VSTR) = rv[1]; }
  __syncthreads();
  LOADK(0); LOADV(0);
  STOREK(sK0); STOREV(sV0);
  LOADK(1);
  STOREK(sK1);
  LOADK(2); LOADV(1);
  __syncthreads();
  f32x16 a0, a1, b0, b1;
  {
#pragma unroll
    for (int ks = 0; ks < NKS; ++ks) {
      const bf16x8 k0 = *(const bf16x8*)(sK0 + l31 * KSTR + ks * 32 + hh * 16);
      const bf16x8 k1 = *(const bf16x8*)(sK0 + (32 + l31) * KSTR + ks * 32 + hh * 16);
      a0 = MFMA(k0, qf[ks], ks == 0 ? negm : a0);
      a1 = MFMA(k1, qf[ks], ks == 0 ? negm : a1);
    }
    if (!FIXED) {
      float mx = fmaxf(a0[0], a1[0]);
#pragma unroll
      for (int r = 1; r < 16; ++r) mx = fmaxf(mx, fmaxf(a0[r], a1[r]));
      mx = half_max(mx);
      mref = mx;
#pragma unroll
      for (int r = 0; r < 16; ++r) { a0[r] -= mx; a1[r] -= mx; negm[r] = -mx; }
    }
  }
#pragma unroll 1
  for (int j = 0; j + 4 < NT; j += 2) {
    unsigned pk[16];
    __syncthreads();
    STOREK(sK0);
    STOREV(sV1);
    attn_half1<DK, true>(sK1, qf, a0, a1, b0, b1, pk, negm, lsum, l31, hh);
    LOADK(j + 3);
    LOADV(j + 2);
    attn_half2<DK, true, FIXED>(sV0, pk, b0, b1, o, negm, mref, lsum, l31, hh, i16, g16);
    __syncthreads();
    STOREK(sK1);
    STOREV(sV0);
    attn_half1<DK, true>(sK0, qf, b0, b1, a0, a1, pk, negm, lsum, l31, hh);
    LOADK(j + 4);
    LOADV(j + 3);
    attn_half2<DK, true, FIXED>(sV1, pk, a0, a1, o, negm, mref, lsum, l31, hh, i16, g16);
  }
  {
    unsigned pk[16];
    constexpr int j = NT - 4;
    __syncthreads();
    STOREK(sK0);
    STOREV(sV1);
    attn_half1<DK, true>(sK1, qf, a0, a1, b0, b1, pk, negm, lsum, l31, hh);
    LOADK(j + 3);
    LOADV(j + 2);
    attn_half2<DK, true, FIXED>(sV0, pk, b0, b1, o, negm, mref, lsum, l31, hh, i16, g16);
    __syncthreads();
    STOREK(sK1);
    STOREV(sV0);
    attn_half1<DK, true>(sK0, qf, b0, b1, a0, a1, pk, negm, lsum, l31, hh);
    LOADV(j + 3);
    attn_half2<DK, true, FIXED>(sV1, pk, a0, a1, o, negm, mref, lsum, l31, hh, i16, g16);
    __syncthreads();
    STOREV(sV1);
    attn_half1<DK, true>(sK1, qf, a0, a1, b0, b1, pk, negm, lsum, l31, hh);
    attn_half2<DK, true, FIXED>(sV0, pk, b0, b1, o, negm, mref, lsum, l31, hh, i16, g16);
    __syncthreads();
    attn_half1<DK, false>(sK0, qf, b0, b1, a0, a1, pk, negm, lsum, l31, hh);
    attn_half2<DK, false, FIXED>(sV1, pk, a0, a1, o, negm, mref, lsum, l31, hh, i16, g16);
  }
#undef LOADK
#undef LOADV
#undef STOREK
#undef STOREV
  lsum += __shfl_xor(lsum, 32);
  const float inv = __builtin_amdgcn_rcpf(lsum);
  const size_t qrow = (size_t)(q0 + l31);
  u32x2 gv[2][4];
#pragma unroll
  for (int d = 0; d < 2; ++d)
#pragma unroll
    for (int g4 = 0; g4 < 4; ++g4) gv[d][g4] = *(const u32x2*)(gate + qrow * HSTR + d * 32 + g4 * 8 + hh * 4);
#pragma unroll
  for (int d = 0; d < 2; ++d)
#pragma unroll
    for (int g4 = 0; g4 < 4; ++g4) {
      const int dv0 = d * 32 + g4 * 8 + hh * 4;
      const float o0 = o[d][4 * g4 + 0] * inv * silu_f(bflo(gv[d][g4].x));
      const float o1 = o[d][4 * g4 + 1] * inv * silu_f(bfhi(gv[d][g4].x));
      const float o2 = o[d][4 * g4 + 2] * inv * silu_f(bflo(gv[d][g4].y));
      const float o3 = o[d][4 * g4 + 3] * inv * silu_f(bfhi(gv[d][g4].y));
      *(u32x2*)(outp + qrow * DM + dv0) = mk2(pack2(o0, o1), pack2(o2, o3));
    }
}

template <int ABL>
DI void phase4(const Params& p, char* smem) {
  const u16* H = (const u16*)(p.ws + OFF_H);
  u16* MG = ABL ? (u16*)(p.ws + OFF_END) : (u16*)(p.ws + OFF_XM);
  const u16* QA = (const u16*)(p.ws + OFF_QA);
  const u16* KA = (const u16*)(p.ws + OFF_KA);
  const u16* VA = (const u16*)(p.ws + OFF_VA);
  const u16* QB = (const u16*)(p.ws + OFF_QB);
  const u16* KB = (const u16*)(p.ws + OFF_KB);
  const u16* VB = (const u16*)(p.ws + OFF_VB);
  const int G = gridDim.x;
  const bool nice = (G % 128 == 0) && (4096 % G == 0);
  float gqm = 0.f, gkm = 0.f;
  for (int i = 0; i < 64; ++i) { gqm = fmaxf(gqm, fabsf(p.e_b_q_norm[i])); gkm = fmaxf(gkm, fabsf(p.e_b_k_norm[i])); }
  const float boundB = 64.f * gqm * gkm * B_QSCALE * 1.01f;
  const bool fixedB = boundB < 48.f;
  for (int v = blockIdx.x; v < 4096; v += G) {
    int type, hidx, qblk;
    if (nice) {
      const int round = v / G, bi = v - round * G;
      const int idx = (bi & 7) * (G >> 3) + (bi >> 3);
      const int xs = idx >> 6;
      qblk = idx & 63;
      type = (xs ^ round) & 1;
      hidx = round * (G >> 7) + (xs >> 1);
    } else {
      type = (v >> 6) & 1; hidx = v >> 7; qblk = v & 63;
    }
    const int b = hidx >> 3, head = hidx & 7;
    if (type == 0) {
      attn_item<96, ABL>(QA + (size_t)(b * 8 + head) * SEQ * 96, KA + (size_t)(b * 8 + head) * TKV * 96, VA + (size_t)(b * 8 + head) * TKV * 64,
                    H + (size_t)(b * SEQ) * HSTR + C_GA + head * 64, MG + (size_t)(ABL ? 0 : b * SEQ) * DM + head * 64, qblk, smem);
    } else {
      const int kvh = head >> 2;
      if (fixedB)
        attn_item<64, ABL, true>(QB + (size_t)(b * 8 + head) * SEQ * 64, KB + (size_t)(b * 2 + kvh) * TKV * 64, VB + (size_t)(b * 2 + kvh) * TKV * 64,
                    H + (size_t)(b * SEQ) * HSTR + C_GB + head * 64, MG + (size_t)(ABL ? 0 : b * SEQ) * DM + 512 + head * 64, qblk, smem, boundB);
      else
      attn_item<64, ABL>(QB + (size_t)(b * 8 + head) * SEQ * 64, KB + (size_t)(b * 2 + kvh) * TKV * 64, VB + (size_t)(b * 2 + kvh) * TKV * 64,
                    H + (size_t)(b * SEQ) * HSTR + C_GB + head * 64, MG + (size_t)(ABL ? 0 : b * SEQ) * DM + 512 + head * 64, qblk, smem);
    }
  }
}

DI void phase6(const Params& p) {
  const float* Z = p.out;
  float* stats = (float*)(p.ws + OFF_STATS);
  const float* modO = (const float*)(p.ws + OFF_MODO);
  u16* A1 = (u16*)(p.ws + OFF_XM);
  const int lane = tid_opaque() & 63;
  const int gw = blockIdx.x * 4 + (tid_opaque() >> 6), nw = gridDim.x * 4;
  for (int row = gw; row < NLAT; row += nw) {
    const float* zr = Z + (size_t)row * DM;
    f32x4 v[4];
#pragma unroll
    for (int i = 0; i < 4; ++i) v[i] = *(const f32x4*)(zr + i * 256 + lane * 4);
    float s = 0.f;
#pragma unroll
    for (int i = 0; i < 4; ++i) s += v[i].x + v[i].y + v[i].z + v[i].w;
    const float mu = wave_sum(s) * (1.f / 1024.f);
    float q = 0.f;
#pragma unroll
    for (int i = 0; i < 4; ++i) {
      const float a = v[i].x - mu, b = v[i].y - mu, c = v[i].z - mu, d = v[i].w - mu;
      q += a * a + b * b + c * c + d * d;
    }
    const float rstd = rsqrtf(wave_sum(q) * (1.f / 1024.f) + LN_EPS);
    if (lane == 0) { stats[row * 2] = mu; stats[row * 2 + 1] = rstd; }
    const float* md = modO + (row >> 13) * 3072;
#pragma unroll
    for (int i = 0; i < 4; ++i) {
      const int k = i * 256 + lane * 4;
      const f32x4 g = *(const f32x4*)(p.e_ln_g + k), bb = *(const f32x4*)(p.e_ln_b + k);
      const f32x4 sh = *(const f32x4*)(md + k), sc = *(const f32x4*)(md + 1024 + k);
      const float y0 = ((v[i].x - mu) * rstd * g.x + bb.x) * (1.f + sc.x) + sh.x;
      const float y1 = ((v[i].y - mu) * rstd * g.y + bb.y) * (1.f + sc.y) + sh.y;
      const float y2 = ((v[i].z - mu) * rstd * g.z + bb.z) * (1.f + sc.z) + sh.z;
      const float y3 = ((v[i].w - mu) * rstd * g.w + bb.w) * (1.f + sc.w) + sh.w;
      *(u32x2*)(A1 + (size_t)row * DM + k) = mk2(pack2(y0, y1), pack2(y2, y3));
    }
  }
}

#define MSTR 320
DI void phase8(const Params& p, char* smem) {
  const u16* H2 = (const u16*)(p.ws + OFF_H);
  const u16* WS = (const u16*)(p.ws + OFF_WS);
  u16* T = (u16*)(p.ws + OFF_XM);
  char* sA = smem;
  char* sB = smem + 128 * GSTR;
  float* sMix = (float*)smem;
  float* sMu = (float*)(smem + 128 * 132 * 4);
  float* sRs = sMu + 128;
  const int t = tid_opaque(), lane = t & 63, w = t >> 6, wm = w >> 1, wn = w & 1, l31 = lane & 31, hh = lane >> 5;
  const int i16 = lane & 15, g16 = (lane >> 4) & 1;
  for (int item = blockIdx.x; item < 512; item += gridDim.x) {
    const int ci = item >> 1, hf = item & 1;
    const int r0 = ci * 128;
    __syncthreads();
#pragma unroll 1
    for (int rr = 0; rr < 32; rr += 4) {
      float sv[4], qv[4];
#pragma unroll
      for (int u = 0; u < 4; ++u) {
        const u16* src = H2 + (size_t)(r0 + w * 32 + rr + u) * 3072 + 1024 + lane * 16;
        const u32x4 a = *(const u32x4*)src, b = *(const u32x4*)(src + 8);
        const float f[16] = {bflo(a.x), bfhi(a.x), bflo(a.y), bfhi(a.y), bflo(a.z), bfhi(a.z), bflo(a.w), bfhi(a.w),
                             bflo(b.x), bfhi(b.x), bflo(b.y), bfhi(b.y), bflo(b.z), bfhi(b.z), bflo(b.w), bfhi(b.w)};
        float s1 = 0.f, s2 = 0.f;
#pragma unroll
        for (int e = 0; e < 16; ++e) { s1 += f[e]; s2 += f[e] * f[e]; }
        sv[u] = s1; qv[u] = s2;
      }
#pragma unroll
      for (int o2 = 32; o2 > 0; o2 >>= 1) {
#pragma unroll
        for (int u = 0; u < 4; ++u) { sv[u] += __shfl_xor(sv[u], o2); qv[u] += __shfl_xor(qv[u], o2); }
      }
      if (lane == 0) {
#pragma unroll
        for (int u = 0; u < 4; ++u) {
          const float mu = sv[u] * (1.f / 1024.f);
          const float var = fmaxf(qv[u] * (1.f / 1024.f) - mu * mu, 0.f);
          sMu[w * 32 + rr + u] = mu; sRs[w * 32 + rr + u] = rsqrtf(var + LN_EPS);
        }
      }
    }
    __syncthreads();
#pragma unroll 1
    for (int gi = 0; gi < 4; ++gi) {
      const int g = hf * 4 + gi;
      f32x16 acc[2][2];
#pragma unroll
      for (int i = 0; i < 2; ++i)
#pragma unroll
        for (int j = 0; j < 2; ++j)
#pragma unroll
          for (int r = 0; r < 16; ++r) acc[i][j][r] = 0.f;
      const int chs = g * 128 + (t & 15) * 8;
      const f32x4 g0 = *(const f32x4*)(p.o_v_ln_g + chs), g1 = *(const f32x4*)(p.o_v_ln_g + chs + 4);
      const f32x4 b0 = *(const f32x4*)(p.o_v_ln_b + chs), b1 = *(const f32x4*)(p.o_v_ln_b + chs + 4);
#pragma unroll 1
      for (int kh = 0; kh < 2; ++kh) {
        __syncthreads();
        const u16* wsp = WS + (size_t)g * 16384 + kh * 64 + (t >> 3) * 128 + (t & 7) * 8;
#pragma unroll
        for (int i = 0; i < 4; ++i)
          *(u32x4*)(sA + ((t >> 3) + 32 * i) * GSTR + (t & 7) * 16) = *(const u32x4*)(wsp + i * 4096);
        const u16* hp = H2 + (size_t)(r0 + kh * 64 + (t >> 4)) * 3072 + 1024 + chs;
#pragma unroll 1
        for (int i = 0; i < 4; ++i) {
          const int row = (t >> 4) + 16 * i;
          const int ql = kh * 64 + row;
          const u32x4 raw = *(const u32x4*)(hp + (size_t)i * 16 * 3072);
          const float mu = sMu[ql], rs = sRs[ql];
          u32x4 o;
          o.x = pack2((bflo(raw.x) - mu) * rs * g0.x + b0.x, (bfhi(raw.x) - mu) * rs * g0.y + b0.y);
          o.y = pack2((bflo(raw.y) - mu) * rs * g0.z + b0.z, (bfhi(raw.y) - mu) * rs * g0.w + b0.w);
          o.z = pack2((bflo(raw.z) - mu) * rs * g1.x + b1.x, (bfhi(raw.z) - mu) * rs * g1.y + b1.y);
          o.w = pack2((bflo(raw.w) - mu) * rs * g1.z + b1.z, (bfhi(raw.w) - mu) * rs * g1.w + b1.w);
          *(u32x4*)(sB + row * MSTR + (t & 15) * 16) = o;
        }
        __syncthreads();
#pragma unroll
        for (int s = 0; s < 4; ++s) {
          bf16x8 af[2], bf[2];
#pragma unroll
          for (int i = 0; i < 2; ++i) af[i] = *(const bf16x8*)(sA + (wm * 64 + i * 32 + l31) * GSTR + s * 32 + hh * 16);
#pragma unroll
          for (int j = 0; j < 2; ++j) {
            const char* ba = sB + (s * 16 + hh * 8 + (i16 >> 2)) * MSTR + (wn * 64 + j * 32 + g16 * 16) * 2 + (i16 & 3) * 8;
            const s16x4 lo = __builtin_amdgcn_ds_read_tr16_b64_v4i16((lds_s16x4*)(ba));
            const s16x4 hi = __builtin_amdgcn_ds_read_tr16_b64_v4i16((lds_s16x4*)(ba + 4 * MSTR));
            bf[j] = __builtin_shufflevector(lo, hi, 0, 1, 2, 3, 4, 5, 6, 7);
          }
#pragma unroll
          for (int i = 0; i < 2; ++i)
#pragma unroll
            for (int j = 0; j < 2; ++j) acc[i][j] = MFMA(af[i], bf[j], acc[i][j]);
        }
      }
      __syncthreads();
#pragma unroll
      for (int i = 0; i < 2; ++i)
#pragma unroll
        for (int j = 0; j < 2; ++j)
#pragma unroll
          for (int r = 0; r < 16; ++r)
            sMix[(wm * 64 + i * 32 + crow(r, hh)) * 132 + wn * 64 + j * 32 + l31] = acc[i][j][r];
      __syncthreads();
#pragma unroll 1
      for (int it = 0; it < 8; ++it) {
        const int idx = t + 256 * it, pr = idx >> 4, cc = idx & 15;
        const u16* hrow = H2 + (size_t)(r0 + pr) * 3072 + g * 128 + cc * 8;
        const u32x4 uu = *(const u32x4*)hrow, gg = *(const u32x4*)(hrow + 2048);
        const float bs = p.o_b_s[g * 128 + pr];
        const f32x4 m0 = *(const f32x4*)(sMix + pr * 132 + cc * 8), m1 = *(const f32x4*)(sMix + pr * 132 + cc * 8 + 4);
        u32x4 o;
        o.x = pack2(bflo(uu.x) * (m0.x + bs) * bflo(gg.x), bfhi(uu.x) * (m0.y + bs) * bfhi(gg.x));
        o.y = pack2(bflo(uu.y) * (m0.z + bs) * bflo(gg.y), bfhi(uu.y) * (m0.w + bs) * bfhi(gg.y));
        o.z = pack2(bflo(uu.z) * (m1.x + bs) * bflo(gg.z), bfhi(uu.z) * (m1.y + bs) * bfhi(gg.z));
        o.w = pack2(bflo(uu.w) * (m1.z + bs) * bflo(gg.w), bfhi(uu.w) * (m1.w + bs) * bfhi(gg.w));
        *(u32x4*)(T + (size_t)(r0 + pr) * DM + g * 128 + cc * 8) = o;
      }
    }
  }
}

DI void phase10(const Params& p) {
  float* Z = p.out;
  const int lane = tid_opaque() & 63;
  const int gw = blockIdx.x * 4 + (tid_opaque() >> 6), nw = gridDim.x * 4;
  for (int row = gw; row < NLAT; row += nw) {
    float* zr = Z + (size_t)row * DM;
    f32x4 v[4];
#pragma unroll
    for (int i = 0; i < 4; ++i) v[i] = *(const f32x4*)(zr + i * 256 + lane * 4);
    float s = 0.f;
#pragma unroll
    for (int i = 0; i < 4; ++i) s += v[i].x + v[i].y + v[i].z + v[i].w;
    const float mu = wave_sum(s) * (1.f / 1024.f);
    float q = 0.f;
#pragma unroll
    for (int i = 0; i < 4; ++i) {
      const float a = v[i].x - mu, b = v[i].y - mu, c = v[i].z - mu, d = v[i].w - mu;
      q += a * a + b * b + c * c + d * d;
    }
    const float rstd = rsqrtf(wave_sum(q) * (1.f / 1024.f) + LN_EPS);
#pragma unroll
    for (int i = 0; i < 4; ++i) {
      const int k = i * 256 + lane * 4;
      const f32x4 g = *(const f32x4*)(p.o_ln_g + k), bb = *(const f32x4*)(p.o_ln_b + k);
      f32x4 y;
      y.x = (v[i].x - mu) * rstd * g.x + bb.x;
      y.y = (v[i].y - mu) * rstd * g.y + bb.y;
      y.z = (v[i].z - mu) * rstd * g.z + bb.z;
      y.w = (v[i].w - mu) * rstd * g.w + bb.w;
      *(f32x4*)(zr + k) = y;
    }
  }
}

#ifdef SELFCHECK
#define OFF_TELE (OFF_STATS - 256u)
DI float blk_max(float v, float* red) {
#pragma unroll
  for (int o = 32; o > 0; o >>= 1) v = fmaxf(v, __shfl_xor(v, o));
  __syncthreads();
  if ((tid_opaque() & 63) == 0) red[tid_opaque() >> 6] = v;
  __syncthreads();
  return fmaxf(fmaxf(red[0], red[1]), fmaxf(red[2], red[3]));
}
DI float blk_sum(float v, float* red) {
  v = wave_sum(v);
  __syncthreads();
  if ((tid_opaque() & 63) == 0) red[tid_opaque() >> 6] = v;
  __syncthreads();
  return red[0] + red[1] + red[2] + red[3];
}
DI void tele_max(const Params& p, int slot, float v) { atomicMax((unsigned*)(p.ws + OFF_TELE) + slot, __float_as_uint(v)); }

DI void check_attn(const Params& p, int s, char* smem) {
  float* sc = (float*)smem;
  float* red = sc + TKV;
  float* ored = red + 8;
  const int t = tid_opaque();
  const int type = s & 1, b = (s >> 1) & 3, head = (s >> 3) & 7, q = (s * 997 + 131 * head + 5) & 8191;
  const int DK = type ? 64 : 96;
  const u16* Q = type ? (const u16*)(p.ws + OFF_QB) + ((size_t)(b * 8 + head) * SEQ + q) * 64 : (const u16*)(p.ws + OFF_QA) + ((size_t)(b * 8 + head) * SEQ + q) * 96;
  const u16* K = type ? (const u16*)(p.ws + OFF_KB) + (size_t)(b * 2 + (head >> 2)) * TKV * 64 : (const u16*)(p.ws + OFF_KA) + (size_t)(b * 8 + head) * TKV * 96;
  const u16* V = type ? (const u16*)(p.ws + OFF_VB) + (size_t)(b * 2 + (head >> 2)) * TKV * 64 : (const u16*)(p.ws + OFF_VA) + (size_t)(b * 8 + head) * TKV * 64;
  const u16* H = (const u16*)(p.ws + OFF_H) + (size_t)(b * SEQ + q) * HSTR + (type ? C_GB : C_GA) + head * 64;
  const u16* MG = (const u16*)(p.ws + OFF_XM) + (size_t)(b * SEQ + q) * DM + (type ? 512 : 0) + head * 64;
  float mx = -1e30f;
  for (int key = t; key < TKV; key += 256) {
    float a = 0.f;
    for (int d = 0; d < DK; ++d) a += bf2f(Q[d]) * bf2f(K[(size_t)key * DK + d]);
    sc[key] = a; mx = fmaxf(mx, a);
  }
  mx = blk_max(mx, red);
  float ls = 0.f;
  for (int key = t; key < TKV; key += 256) { const float pp = exp2f(sc[key] - mx); sc[key] = pp; ls += pp; }
  ls = blk_sum(ls, red);
  __syncthreads();
  {
    const int dv = t & 63, part = t >> 6;
    float a = 0.f;
    for (int key = part; key < TKV; key += 4) a += sc[key] * bf2f(V[(size_t)key * 64 + dv]);
    ored[part * 64 + dv] = a;
  }
  __syncthreads();
  if (t < 64) {
    const float o = (ored[t] + ored[64 + t] + ored[128 + t] + ored[192 + t]) / ls;
    const float ex = o * silu_f(bf2f(H[t]));
    const float got = bf2f(MG[t]);
    float md = fabsf(ex - got), me = fabsf(ex);
#pragma unroll
    for (int o2 = 32; o2 > 0; o2 >>= 1) { md = fmaxf(md, __shfl_xor(md, o2)); me = fmaxf(me, __shfl_xor(me, o2)); }
    if (t == 0) tele_max(p, 0, md / (me + 1e-20f));
  }
  __syncthreads();
}

DI float rope_ref(float v, float partner, bool first, float pos, float invf) {
  const float ang = pos * invf;
  return first ? (v * cosf(ang) - partner * sinf(ang)) : (v * cosf(ang) + partner * sinf(ang));
}

DI void check_token(const Params& p, int row, char* smem) {
  float* xm = (float*)smem;
  float* hr = xm + 1024;
  float* nq = hr + 2464;
  float* nkv = nq + 384;
  float* qa = nkv + 256;
  float* kva = qa + 768;
  float* red = kva + 1024;
  float* dmax = red + 8;
  const int t = tid_opaque();
  const bool lat = row < NLAT;
  int b, sq, tk;
  if (lat) { b = row >> 13; sq = row & 8191; tk = CTXL + sq; } else { b = (row - NLAT) >> 8; tk = (row - NLAT) & 255; sq = 0; }
  __syncthreads();
  if (t < 2) ((unsigned*)dmax)[t] = 0u;
  const float* cv = lat ? p.c + b * 1024 : p.c_ctx;
  const float* src = lat ? p.x + (size_t)row * DM : p.ctx + (size_t)(row - NLAT) * DM;
  for (int k = t; k < 1024; k += 256) {
    float sh = p.e_b_mod[k], scl = p.e_b_mod[1024 + k];
    for (int j = 0; j < 1024; ++j) {
      const float sv = cv[j] / (1.f + expf(-cv[j]));
      sh += sv * p.e_w_mod[(size_t)j * 3072 + k];
      scl += sv * p.e_w_mod[(size_t)j * 3072 + 1024 + k];
    }
    xm[k] = src[k] * (1.f + scl) + sh;
  }
  __syncthreads();
  for (int col = t; col < EVEN_IN; col += 256) {
    float a = 0.f;
    for (int k = 0; k < 1024; ++k) a += xm[k] * p.e_w_in[(size_t)k * EVEN_IN + col];
    hr[col] = a;
  }
  __syncthreads();
  float s1 = 0.f, s2 = 0.f;
  for (int k = t; k < 384; k += 256) s1 += hr[C_CQ + k] * hr[C_CQ + k];
  for (int k = t; k < 256; k += 256) s2 += hr[C_CKV + k] * hr[C_CKV + k];
  s1 = blk_sum(s1, red);
  s2 = blk_sum(s2, red);
  const float rq = rsqrtf(s1 / 384.f + LN_EPS), rkv = rsqrtf(s2 / 256.f + LN_EPS);
  for (int k = t; k < 384; k += 256) nq[k] = hr[C_CQ + k] * rq * p.e_a_q_norm[k];
  for (int k = t; k < 256; k += 256) nkv[k] = hr[C_CKV + k] * rkv * p.e_a_kv_norm[k];
  __syncthreads();
  for (int col = t; col < 768; col += 256) { float a = 0.f; for (int k = 0; k < 384; ++k) a += nq[k] * p.e_a_w_uq[(size_t)k * 768 + col]; qa[col] = a; }
  for (int col = t; col < 1024; col += 256) { float a = 0.f; for (int k = 0; k < 256; ++k) a += nkv[k] * p.e_a_w_ukv[(size_t)k * 1024 + col]; kva[col] = a; }
  __syncthreads();
  const float posr = (float)(sq >> 6), posc = (float)(sq & 63);
  float md = 0.f, me = 0.f;
  for (int idx = t; idx < 8 * 96; idx += 256) {
    const int head = idx / 96, d = idx % 96;
    if (lat) {
      float v = qa[head * 96 + d];
      if (d >= 64) {
        const int i = d - 64, axis = i >> 4, ii = i & 15, fi = ii & 7;
        const float invf = powf(10000.f, -(float)(2 * fi) / 16.f);
        const float partner = qa[head * 96 + 64 + axis * 16 + (ii ^ 8)];
        v = rope_ref(v, partner, ii < 8, axis ? posc : posr, invf);
      }
      v *= A_QSCALE;
      const float got = bf2f(((const u16*)(p.ws + OFF_QA))[((size_t)(b * 8 + head) * SEQ + sq) * 96 + d]);
      md = fmaxf(md, fabsf(v - got)); me = fmaxf(me, fabsf(v));
    }
    {
      float v;
      if (d < 64) v = kva[head * 128 + d];
      else {
        const int i = d - 64, axis = i >> 4, ii = i & 15, fi = ii & 7;
        v = hr[C_KR + i];
        if (lat) {
          const float invf = powf(10000.f, -(float)(2 * fi) / 16.f);
          v = rope_ref(v, hr[C_KR + axis * 16 + (ii ^ 8)], ii < 8, axis ? posc : posr, invf);
        }
      }
      const float got = bf2f(((const u16*)(p.ws + OFF_KA))[((size_t)(b * 8 + head) * TKV + tk) * 96 + d]);
      md = fmaxf(md, fabsf(v - got)); me = fmaxf(me, fabsf(v));
    }
    if (d < 64) {
      const float v = kva[head * 128 + 64 + d];
      const float got = bf2f(((const u16*)(p.ws + OFF_VA))[((size_t)(b * 8 + head) * TKV + tk) * 64 + d]);
      md = fmaxf(md, fabsf(v - got)); me = fmaxf(me, fabsf(v));
    }
  }
  for (int idx = t; idx < 12 * 64; idx += 256) {
    const int hd = idx >> 6, d = idx & 63;
    const int axis = d >> 5, ii = d & 31, fi = ii & 15;
    const float invf = powf(10000.f, -(float)(2 * fi) / 32.f);
    if (hd < 8) {
      if (lat) {
        float ss = 0.f;
        for (int e = 0; e < 64; ++e) ss += hr[C_QB + hd * 64 + e] * hr[C_QB + hd * 64 + e];
        const float rr = rsqrtf(ss / 64.f + LN_EPS);
        float v = hr[C_QB + hd * 64 + d] * rr * p.e_b_q_norm[d];
        const int dp = axis * 32 + (ii ^ 16);
        const float partner = hr[C_QB + hd * 64 + dp] * rr * p.e_b_q_norm[dp];
        v = rope_ref(v, partner, ii < 16, axis ? posc : posr, invf) * B_QSCALE;
        const float got = bf2f(((const u16*)(p.ws + OFF_QB))[((size_t)(b * 8 + hd) * SEQ + sq) * 64 + d]);
        md = fmaxf(md, fabsf(v - got)); me = fmaxf(me, fabsf(v));
      }
    } else if (hd < 10) {
      const int kh = hd - 8;
      float ss = 0.f;
      for (int e = 0; e < 64; ++e) ss += hr[C_KB + kh * 64 + e] * hr[C_KB + kh * 64 + e];
      const float rr = rsqrtf(ss / 64.f + LN_EPS);
      float v = hr[C_KB + kh * 64 + d] * rr * p.e_b_k_norm[d];
      if (lat) {
        const int dp = axis * 32 + (ii ^ 16);
        const float partner = hr[C_KB + kh * 64 + dp] * rr * p.e_b_k_norm[dp];
        v = rope_ref(v, partner, ii < 16, axis ? posc : posr, invf);
      }
      const float got = bf2f(((const u16*)(p.ws + OFF_KB))[((size_t)(b * 2 + kh) * TKV + tk) * 64 + d]);
      md = fmaxf(md, fabsf(v - got)); me = fmaxf(me, fabsf(v));
    } else {
      const int kh = hd - 10;
      const float v = hr[C_VB + kh * 64 + d];
      const float got = bf2f(((const u16*)(p.ws + OFF_VB))[((size_t)(b * 2 + kh) * TKV + tk) * 64 + d]);
      md = fmaxf(md, fabsf(v - got)); me = fmaxf(me, fabsf(v));
    }
  }
  for (int idx = t; idx < 1024; idx += 256) {
    const int col = (idx < 512) ? C_GA + idx : C_GB + idx - 512;
    const float got = bf2f(((const u16*)(p.ws + OFF_H))[(size_t)row * HSTR + col]);
    md = fmaxf(md, fabsf(hr[col] - got)); me = fmaxf(me, fabsf(hr[col]));
  }
  md = blk_max(md, red);
  me = blk_max(me, red);
  if (t == 0) tele_max(p, 1, md / (me + 1e-20f));
  __syncthreads();
}

DI void check_merge_y(const Params& p, int s, char* smem) {
  float* mg = (float*)smem;
  float* red = mg + 1024;
  const int t = tid_opaque();
  const int row = (s * 4099 + 33) & 32767, b = row >> 13;
  __syncthreads();
  for (int k = t; k < 1024; k += 256) mg[k] = bf2f(((const u16*)(p.ws + OFF_XM))[(size_t)row * DM + k]);
  __syncthreads();
  float md = 0.f, me = 0.f;
  for (int col = t; col < 1024; col += 256) {
    float a = 0.f;
    for (int k = 0; k < 1024; ++k) a += mg[k] * p.e_w_out[(size_t)k * 1024 + col];
    const float gate = ((const float*)(p.ws + OFF_MODE))[b * 3072 + 2048 + col];
    const float got = (p.out[(size_t)row * DM + col] - ALPHA * p.x[(size_t)row * DM + col]);
    md = fmaxf(md, fabsf(gate * a - got)); me = fmaxf(me, fabsf(gate * a));
  }
  md = blk_max(md, red);
  me = blk_max(me, red);
  if (t == 0) tele_max(p, 2, md / (me + 1e-20f));
  __syncthreads();
}
DI float tele_digit(float x) { return x < 0.003f ? 1.f : x < 0.01f ? 2.f : x < 0.03f ? 3.f : x < 0.1f ? 4.f : x < 0.3f ? 5.f : x < 1.f ? 6.f : 7.f; }
#endif

#define OFF_BAR 110592u
#define XB_TMO      128
#define XB_XCNT(j)  (256  + 64 * (j))
#define XB_XSUB(j)  (1280 + 64 * (j))
#define XB_XGEN(j)  (2304 + 64 * (j))
#define XB_TOP      3328
#define XB_TOPGEN   3392
#define XCD_BAR_WORDS 3456
#define XB_SPIN_CAP (1u << 18)
#define LAS __attribute__((address_space(3)))
DI unsigned xb_ld(unsigned* p)              { return __hip_atomic_load(p, __ATOMIC_RELAXED, __HIP_MEMORY_SCOPE_AGENT); }
DI unsigned xb_add(unsigned* p, unsigned v) { return __hip_atomic_fetch_add(p, v, __ATOMIC_RELAXED, __HIP_MEMORY_SCOPE_AGENT); }
DI unsigned xb_xcc_id() { return (unsigned)__builtin_amdgcn_s_getreg((3 << 11) | 20) & 0xFu; }
#define XB_SPIN(cond, bar) do { unsigned _sp = 0; while (cond) { __builtin_amdgcn_s_sleep(1); \
    if ((++_sp & 255u) == 0u) { if (xb_ld(&(bar)[XB_TMO])) break; if (_sp > XB_SPIN_CAP) { atomicAdd(&(bar)[XB_TMO], 1u); break; } } } } while (0)
struct XcdBarrier { unsigned* bar; unsigned x; volatile LAS unsigned* st; };
DI XcdBarrier xcd_barrier_post(unsigned* bar, volatile LAS unsigned* st) {
  XcdBarrier b; b.bar = bar; b.x = xb_xcc_id(); b.st = st;
  if (tid_opaque() == 0) (void)xb_add(&bar[XB_XCNT(b.x)], 1u);
  return b;
}
DI void xcd_barrier_complete(unsigned* bar, unsigned x, unsigned& nloc, unsigned& nx) {
  const unsigned G = gridDim.x * gridDim.y * gridDim.z;
  unsigned sum, cnt, mine, sp = 0u;
  for (;;) {
    sum = 0u; cnt = 0u; mine = 0u;
#pragma unroll
    for (unsigned j = 0; j < 16; ++j) { const unsigned c = xb_ld(&bar[XB_XCNT(j)]); sum += c; cnt += (c > 0u) ? 1u : 0u; mine = (j == x) ? c : mine; }
    if (sum == G) break;
    __builtin_amdgcn_s_sleep(1);
    if ((++sp & 255u) == 0u) { if (xb_ld(&bar[XB_TMO])) break; if (sp > XB_SPIN_CAP) { atomicAdd(&bar[XB_TMO], 1u); break; } }
  }
  nloc = mine > 0u ? mine : 1u; nx = cnt > 0u ? cnt : 1u;
}
DI void xcd_barrier(const XcdBarrier& b) {
  asm volatile("s_waitcnt vmcnt(0)" ::: "memory");
  __syncthreads();
  if (tid_opaque() == 0) {
    unsigned* bar = b.bar;
    __builtin_amdgcn_s_waitcnt(0);
    unsigned nloc = b.st[0], nx = b.st[1];
    if (nloc == 0u) { xcd_barrier_complete(bar, b.x, nloc, nx); b.st[0] = nloc; b.st[1] = nx; }
    const unsigned old = xb_add(&bar[XB_XSUB(b.x)], 1u);
    const unsigned gen = old / nloc;
    if (old + 1u == (gen + 1u) * nloc) {
      __builtin_amdgcn_fence(__ATOMIC_RELEASE, "agent");
      asm volatile("s_waitcnt vmcnt(0)" ::: "memory");
      const unsigned og = xb_add(&bar[XB_TOP], 1u);
      const unsigned tg = og / nx;
      if (og + 1u == (tg + 1u) * nx) xb_add(&bar[XB_TOPGEN], 1u);
      else XB_SPIN(xb_ld(&bar[XB_TOPGEN]) == tg, bar);
      __builtin_amdgcn_fence(__ATOMIC_ACQUIRE, "agent");
      xb_add(&bar[XB_XGEN(b.x)], 1u);
      asm volatile("s_waitcnt vmcnt(0)" ::: "memory");
    } else {
      XB_SPIN(xb_ld(&bar[XB_XGEN(b.x)]) == gen, bar);
      __builtin_amdgcn_fence(__ATOMIC_ACQUIRE, "agent");
      asm volatile("s_waitcnt vmcnt(0)" ::: "memory");
    }
  }
  __syncthreads();
}

template <int SM, int SN>
DI bool tile_map(int it, int MT, int NTL, int& m, int& n) {
  const int x = blockIdx.x & 7, r = blockIdx.x >> 3;
  const int nsn = (NTL + SN - 1) / SN;
  const int S = it * 8 + x;
  const int sm = S / nsn, sn = S - sm * nsn;
  m = sm * SM + r / SN;
  n = sn * SN + r % SN;
  return (m < MT) && (n < NTL);
}
template <int SM, int SN>
DI int tile_iters(int MT, int NTL) { return (((MT + SM - 1) / SM) * ((NTL + SN - 1) / SN) + 7) / 8; }

#ifndef USE_T256
#define USE_T256 1
#endif
#define SMEM_BYTES (2 * GSTAGE + 512)
__global__ void __launch_bounds__(256, 2) fwd_megakernel(Params p) {
  extern __shared__ __attribute__((aligned(16))) char smem[];
  __shared__ __attribute__((aligned(16))) unsigned xb_words[4];
  cg::grid_group grid = cg::this_grid();
  const int G = gridDim.x;
  char* ws = p.ws;
  if (tid_opaque() < 4) xb_words[tid_opaque()] = 0u;
  __syncthreads();
#ifdef REP_PHASE
#define PH_REPS(n) (((n) == REP_PHASE) ? 2 : 1)
#else
#define PH_REPS(n) 1
#endif
#define PH_BEGIN(n) for (int rep_ = 0; rep_ < PH_REPS(n); ++rep_) { xcd_barrier(xb);
#define PH_END }
  const XcdBarrier xb = xcd_barrier_post((unsigned*)(ws + OFF_BAR), (volatile LAS unsigned*)&xb_words[0]);
  if (p.phase_lo == 0x7fffffff) grid.sync();
  for (int rep_ = 0; rep_ < PH_REPS(0); ++rep_) { if (rep_) xcd_barrier(xb);
    phase0(p, smem);
#ifdef SELFCHECK
    if (blockIdx.x == 0 && tid_opaque() < 8) ((unsigned*)(ws + OFF_TELE))[tid_opaque()] = 0u;
#endif
  }
  PH_BEGIN(1) phase1(p); PH_END
  PH_BEGIN(2) {
    const int NTN = 20, MTN = 264, NTILES = MTN * NTN;
    if (USE_T256 && G == 512) {
      for (int tI = blockIdx.x; tI < 128 * NTN; tI += G)
        gemm_tile256((const u16*)(ws + OFF_XM), DM, (const u16*)(ws + OFF_WINE), DM, DM, (tI / NTN) * 256, (tI % NTN) * 128, smem, EpiH{(u16*)(ws + OFF_H)});
      for (int tI = blockIdx.x; tI < 8 * NTN; tI += G)
        gemm_tile<false>((const u16*)(ws + OFF_XM), DM, (const u16*)(ws + OFF_WINE), DM, DM, NLAT + (tI / NTN) * 128, (tI % NTN) * 128, smem, EpiH{(u16*)(ws + OFF_H)});
    } else
    for (int tI = blockIdx.x; tI < NTILES; tI += G)
      gemm_tile<false>((const u16*)(ws + OFF_XM), DM, (const u16*)(ws + OFF_WINE), DM, DM, (tI / NTN) * 128, (tI % NTN) * 128, smem,
                       EpiH{(u16*)(ws + OFF_H)});
  } PH_END
  PH_BEGIN(3) {
    const int NQ = 256 * 6, NKV = 264 * 8;
    for (int tI = blockIdx.x; tI < NKV + NQ; tI += G) {
      if (tI >= NQ) {
        const int u = tI - NQ;
        gemm_tile<true>((const u16*)(ws + OFF_H) + C_CKV, HSTR, (const u16*)(ws + OFF_WUKV), 256, 256, (u / 8) * 128, (u % 8) * 128, smem,
                        EpiKVA{(u16*)(ws + OFF_KA), (u16*)(ws + OFF_VA), false});
      } else {
        gemm_tile<true>((const u16*)(ws + OFF_H) + C_CQ, HSTR, (const u16*)(ws + OFF_WUQ), 384, 384, (tI / 6) * 128, (tI % 6) * 128, smem,
                        EpiQA{(u16*)(ws + OFF_QA), 0, 0, 0, false, 0.f});
      }
    }
    phase3_elem(p);
#ifdef REP_ELEM
    __syncthreads();
    phase3_elem(p);
#endif
  } PH_END
  PH_BEGIN(4) phase4<0>(p, smem); PH_END
#ifdef SHADOW4
  xcd_barrier(xb);
  phase4<SHADOW4>(p, smem);
#endif
#ifdef SELFCHECK
  grid.sync();
  for (int sI = blockIdx.x; sI < 128; sI += G) {
    if (sI < 64) check_attn(p, sI, smem);
    else { const int u = sI - 64; check_token(p, (u < 56) ? ((u * 5003 + 17) & 32767) : (NLAT + ((u * 131 + 7) & 1023)), smem); }
  }
#endif
  PH_BEGIN(5) {
    const int NTN = 8, MTN = 256, NTILES = MTN * NTN;
    if (USE_T256 && G == 512) {
      for (int tI = blockIdx.x; tI < 128 * NTN; tI += G)
        gemm_tile256((const u16*)(ws + OFF_XM), DM, (const u16*)(ws + OFF_WOUTE), DM, DM, (tI / NTN) * 256, (tI % NTN) * 128, smem,
                     EpiZ{p.x, (const float*)(ws + OFF_MODE), p.out, 0.f});
    } else
    for (int tI = blockIdx.x; tI < NTILES; tI += G)
      gemm_tile<false>((const u16*)(ws + OFF_XM), DM, (const u16*)(ws + OFF_WOUTE), DM, DM, (tI / NTN) * 128, (tI % NTN) * 128, smem,
                       EpiZ{p.x, (const float*)(ws + OFF_MODE), p.out, 0.f});
  } PH_END
#ifdef SELFCHECK
  grid.sync();
  for (int sI = blockIdx.x; sI < 32; sI += G) check_merge_y(p, sI, smem);
#endif
  PH_BEGIN(6) phase6(p); PH_END
  PH_BEGIN(7) {
    const int NTN = 24, MTN = 256, NTILES = MTN * NTN;
    if (USE_T256 && G == 512) {
      for (int tI = blockIdx.x; tI < 128 * NTN; tI += G)
        gemm_tile256((const u16*)(ws + OFF_XM), DM, (const u16*)(ws + OFF_WINO), DM, DM, (tI / NTN) * 256, (tI % NTN) * 128, smem, EpiH2{(u16*)(ws + OFF_H), false});
    } else
    for (int tI = blockIdx.x; tI < NTILES; tI += G)
      gemm_tile<false>((const u16*)(ws + OFF_XM), DM, (const u16*)(ws + OFF_WINO), DM, DM, (tI / NTN) * 128, (tI % NTN) * 128, smem,
                       EpiH2{(u16*)(ws + OFF_H), false});
  } PH_END
#ifdef SHADOW7
  xcd_barrier(xb);
  {
    const int NTN = 24, MTN = 256;
    for (int it = 0; it < tile_iters<8, 8>(MTN, NTN); ++it) { int tm, tn;
      if (tile_map<8, 8>(it, MTN, NTN, tm, tn))
        gemm_tile<false, EpiNull, SHADOW7>((const u16*)(ws + OFF_XM), DM, (const u16*)(ws + OFF_WINO), DM, DM, tm * 128, tn * 128, smem, EpiNull{(u16*)(ws + OFF_H)}); }
  }
#endif
  PH_BEGIN(8) phase8(p, smem); PH_END
  PH_BEGIN(9) {
    const int NTN = 8, MTN = 256, NTILES = MTN * NTN;
    if (USE_T256 && G == 512) {
      for (int tI = blockIdx.x; tI < 128 * NTN; tI += G)
        gemm_tile256((const u16*)(ws + OFF_XM), DM, (const u16*)(ws + OFF_WOUTO), DM, DM, (tI / NTN) * 256, (tI % NTN) * 128, smem,
                     EpiOut{p.out, (const float*)(ws + OFF_STATS), p.e_ln_g, p.e_ln_b, (const float*)(ws + OFF_MODO), 0.f, 0.f, 0.f});
    } else
    for (int tI = blockIdx.x; tI < NTILES; tI += G)
      gemm_tile<false>((const u16*)(ws + OFF_XM), DM, (const u16*)(ws + OFF_WOUTO), DM, DM, (tI / NTN) * 128, (tI % NTN) * 128, smem,
                       EpiOut{p.out, (const float*)(ws + OFF_STATS), p.e_ln_g, p.e_ln_b, (const float*)(ws + OFF_MODO), 0.f, 0.f, 0.f});
  } PH_END
  PH_BEGIN(10) phase10(p); PH_END
#ifdef EXTRA_SYNCS
  for (int i_ = 0; i_ < EXTRA_SYNCS; ++i_) xcd_barrier(xb);
#endif
#ifdef TELE_GRID
  grid.sync();
  if (blockIdx.x == 0 && tid_opaque() == 0) p.out[0] += (float)gridDim.x;
#endif
#ifdef TELE_CYC
  grid.sync();
  if (blockIdx.x == 0 && tid_opaque() == 0) p.out[0] += __hip_atomic_load(&tele_cyc_out[0], __ATOMIC_RELAXED, __HIP_MEMORY_SCOPE_AGENT);
#endif
#ifdef SELFCHECK
  grid.sync();
  if (blockIdx.x == 0 && tid_opaque() == 0) {
    const float* tl = (const float*)(ws + OFF_TELE);
    p.out[0] += 1000.f * tele_digit(tl[SELFCHECK_A]) + 100.f * tele_digit(tl[SELFCHECK_B]);
  }
#endif
}

extern "C" void kernel_launch(void* const* d_in, const int* in_sizes, int n_in, void* d_out, int out_size, void* d_ws, size_t ws_size,
                              hipStream_t stream) {
  static int grid_blocks = 0;
  if (!grid_blocks) {
    int dev = 0, cus = 0, per_cu = 0;
    hipGetDevice(&dev);
    hipDeviceGetAttribute(&cus, hipDeviceAttributeMultiprocessorCount, dev);
    hipFuncSetAttribute((const void*)fwd_megakernel, hipFuncAttributeMaxDynamicSharedMemorySize, SMEM_BYTES);
    hipOccupancyMaxActiveBlocksPerMultiprocessor(&per_cu, fwd_megakernel, 256, SMEM_BYTES);
    if (per_cu > 2) per_cu = 2;
    if (per_cu < 1) per_cu = 1;
    grid_blocks = cus * per_cu;
    if ((size_t)OFF_END > ws_size) fprintf(stderr, "workspace too small: need %u have %zu\n", OFF_END, ws_size);
  }
  Params p{};
  const float** f = (const float**)&p;
  for (int i = 0; i < 26; ++i) f[i] = (const float*)d_in[i];
  p.out = (float*)d_out;
  p.ws = (char*)d_ws;
  p.phase_lo = 0;
  p.phase_hi = 10;
  void* args[] = {&p};
  hipMemsetAsync((char*)d_ws + OFF_BAR, 0, XCD_BAR_WORDS * sizeof(unsigned), stream);
  hipError_t e = hipLaunchCooperativeKernel((void*)fwd_megakernel, dim3(grid_blocks), dim3(256), args, SMEM_BYTES, stream);
  if (e != hipSuccess) fprintf(stderr, "cooperative launch failed: %s (grid %d)\n", hipGetErrorString(e), grid_blocks);
}
```
